# Optimizing an MI355X kernel written in HIP

```python
import math
import jax, jax.numpy as jnp
from jax import lax
import numpy as np

D_MODEL = 1024
BATCH = 8
SEQ = 2048
DEPTH = 1
DEC_BATCH = 128
DEC_SEQ = 4
PAST_LEN = 16384
PAGE_SIZE = 128

N_META = 16
POOL_WIDTH = D_MODEL // 2
POOL_WINDOWS = (2, 4, 8, 16)
POOL_GROUPS = len(POOL_WINDOWS)
POOL_GROUP_DIM = POOL_WIDTH // POOL_GROUPS
POOL_BUF = max(POOL_WINDOWS) - 1
GLA_HEADS = 4
GLA_WIDTH = D_MODEL // 2
GLA_DV = GLA_WIDTH // GLA_HEADS
GLA_DK = GLA_DV // 2
GLA_KW = GLA_HEADS * GLA_DK
GLA_GATE_RANK = 16
GLA_TAU = 16.0
GLA_CHUNK = 64
D_FF = -(-8 * D_MODEL // (3 * 256)) * 256
EPS = 1e-6

_IN_SIZES = (POOL_WIDTH, GLA_KW, GLA_KW, GLA_WIDTH, GLA_WIDTH, GLA_GATE_RANK, D_MODEL, D_MODEL)
IN_DIM = sum(_IN_SIZES)
IN_SPLIT_IDX = tuple(int(s) for s in np.cumsum(_IN_SIZES)[:-1])

kernel_name = 'hybrid_pool_gla_gated_decoder_step'


def _rmsnorm(x, g):
    xf = x.astype(jnp.float32)
    y = xf * lax.rsqrt(jnp.mean(xf * xf, axis=-1, keepdims=True) + EPS)
    return (y * g.astype(jnp.float32)).astype(x.dtype)


def _pool_mix(u, buf, start_pos, w_group, scale):
    T = u.shape[1]
    ext = jnp.concatenate([buf.astype(u.dtype), u], axis=1)
    c = jnp.cumsum(ext.astype(jnp.float32), axis=1)
    c = jnp.pad(c, ((0, 0), (1, 0), (0, 0)))
    pos = start_pos + jnp.arange(T)
    uf = u.astype(jnp.float32)
    outs = []
    for gi, w in enumerate(POOL_WINDOWS):
        sl = slice(gi * POOL_GROUP_DIM, (gi + 1) * POOL_GROUP_DIM)
        hi = c[:, POOL_BUF + 1:POOL_BUF + 1 + T, sl]
        lo = c[:, POOL_BUF + 1 - w:POOL_BUF + 1 - w + T, sl]
        cnt = jnp.minimum(w, pos + 1).astype(jnp.float32)[None, :, None]
        outs.append((hi - lo) / cnt - uf[:, :, sl])
    pooled = jnp.stack(outs, axis=2).astype(u.dtype)
    mixed = jnp.einsum('btgc,gcd->btgd', pooled, w_group)
    out = mixed.reshape(u.shape) * scale
    return out, ext[:, -POOL_BUF:]


def _gla_segment(q, k, v, g, S, chunk):
    B, T, H, _ = q.shape
    n = T // chunk

    def to_chunks(a):
        return a.reshape(B, n, chunk, H, a.shape[-1]).transpose(1, 0, 3, 2, 4)

    mask = jnp.tril(jnp.ones((chunk, chunk), dtype=bool))

    def step(S, inp):
        qc, kc, vc, gc = inp
        b = jnp.cumsum(gc, axis=2)
        qe = qc * jnp.exp(b)
        ke = kc * jnp.exp(-b)
        att = jnp.where(mask, jnp.einsum('bhik,bhjk->bhij', qe, ke), 0.0)
        o = jnp.einsum('bhik,bhkv->bhiv', qe, S) + jnp.einsum('bhij,bhjv->bhiv', att, vc)
        b_last = b[:, :, -1:, :]
        S = jnp.exp(b_last[:, :, 0, :])[..., None] * S + jnp.einsum(
            'bhjk,bhjv->bhkv', kc * jnp.exp(b_last - b), vc)
        return S, o

    S, o = lax.scan(step, S, (to_chunks(q), to_chunks(k), to_chunks(v), to_chunks(g)))
    o = o.transpose(1, 0, 3, 2, 4).reshape(B, T, H, v.shape[-1])
    return o, S


def _gla(q, k, v, g, S, seg_lens):
    outs = []
    start = 0
    for L in seg_lens:
        chunk = math.gcd(L, GLA_CHUNK)
        sl = slice(start, start + L)
        o, S = _gla_segment(q[:, sl], k[:, sl], v[:, sl], g[:, sl], S, chunk)
        outs.append(o)
        start += L
    return jnp.concatenate(outs, axis=1), S


def _layer(x, pool_buf, gla_S, start_pos, seg_lens, g_mix, w_in, w_gk_up, b_gk,
           w_pool_group, pool_scale, w_pool_proj, g_gla_norm, w_gla_proj, w_out,
           g_ffn, w_ffn_in, w_ffn_out):
    B, T, _ = x.shape
    h = _rmsnorm(x, g_mix)
    u, q, k, v, og, zr, ga, gb = jnp.split(h @ w_in, IN_SPLIT_IDX, axis=-1)
    pool_out, new_buf = _pool_mix(u, pool_buf, start_pos, w_pool_group, pool_scale)
    y_a = pool_out @ w_pool_proj
    f32 = jnp.float32
    qh = q.reshape(B, T, GLA_HEADS, GLA_DK).astype(f32) * (GLA_DK ** -0.5)
    kh = k.reshape(B, T, GLA_HEADS, GLA_DK).astype(f32)
    vh = v.reshape(B, T, GLA_HEADS, GLA_DV).astype(f32)
    loga = jax.nn.log_sigmoid((zr @ w_gk_up + b_gk).astype(f32)) / GLA_TAU
    loga = loga.reshape(B, T, GLA_HEADS, GLA_DK)
    o, new_S = _gla(qh, kh, vh, loga, gla_S.astype(f32), seg_lens)
    o = o * lax.rsqrt(jnp.mean(o * o, axis=-1, keepdims=True) + EPS) * g_gla_norm.astype(f32)
    o = o * jax.nn.silu(og.reshape(B, T, GLA_HEADS, GLA_DV).astype(f32))
    y_b = o.reshape(B, T, GLA_WIDTH).astype(x.dtype) @ w_gla_proj
    merged = jax.nn.sigmoid(ga) * y_a + jax.nn.sigmoid(gb) * y_b
    x = x + merged @ w_out
    h2 = _rmsnorm(x, g_ffn)
    gate, up = jnp.split(h2 @ w_ffn_in, 2, axis=-1)
    x = x + (jax.nn.silu(gate) * up) @ w_ffn_out
    return x, new_buf, new_S.astype(x.dtype)


def setup_inputs(seed: int = 0) -> dict:
    key = jax.random.key(seed)
    ks = jax.random.split(key, 20)
    f32 = jnp.float32
    nrm = lambda k, s, sc: jax.random.normal(k, s, f32) * sc
    return {
        'x_prompt': nrm(ks[0], (BATCH, SEQ, D_MODEL), 1.0),
        'x_sample': nrm(ks[1], (DEC_BATCH, DEC_SEQ, D_MODEL), 1.0),
        'state_pool': nrm(ks[2], (DEPTH, DEC_BATCH, POOL_BUF, POOL_WIDTH), 1.0),
        'state_gla': nrm(ks[3], (DEPTH, DEC_BATCH, GLA_HEADS, GLA_DK, GLA_DV), 1.0),
        'meta_tokens': nrm(ks[4], (N_META, D_MODEL), 1.0),
        'g_mix': 1.0 + nrm(ks[5], (DEPTH, D_MODEL), 0.05),
        'w_in': nrm(ks[6], (DEPTH, D_MODEL, IN_DIM), D_MODEL ** -0.5),
        'w_gk_up': nrm(ks[7], (DEPTH, GLA_GATE_RANK, GLA_KW), GLA_GATE_RANK ** -0.5),
        'b_gk': nrm(ks[8], (DEPTH, GLA_KW), 0.01),
        'w_pool_group': nrm(ks[9], (DEPTH, POOL_GROUPS, POOL_GROUP_DIM, POOL_GROUP_DIM), POOL_GROUP_DIM ** -0.5),
        'pool_scale': 1.0 + nrm(ks[10], (DEPTH, POOL_WIDTH), 0.1),
        'w_pool_proj': nrm(ks[11], (DEPTH, POOL_WIDTH, D_MODEL), POOL_WIDTH ** -0.5),
        'g_gla_norm': 1.0 + nrm(ks[12], (DEPTH, GLA_DV), 0.05),
        'w_gla_proj': nrm(ks[13], (DEPTH, GLA_WIDTH, D_MODEL), GLA_WIDTH ** -0.5),
        'w_out': nrm(ks[14], (DEPTH, D_MODEL, D_MODEL), D_MODEL ** -0.5),
        'g_ffn': 1.0 + nrm(ks[15], (DEPTH, D_MODEL), 0.05),
        'w_ffn_in': nrm(ks[16], (DEPTH, D_MODEL, 2 * D_FF), D_MODEL ** -0.5),
        'w_ffn_out': nrm(ks[17], (DEPTH, D_FF, D_MODEL), D_FF ** -0.5),
        'g_final': 1.0 + nrm(ks[18], (D_MODEL,), 0.05),
    }


def reference(x_prompt, x_sample, state_pool, state_gla, meta_tokens, g_mix, w_in, w_gk_up,
              b_gk, w_pool_group, pool_scale, w_pool_proj, g_gla_norm, w_gla_proj, w_out,
              g_ffn, w_ffn_in, w_ffn_out, g_final):
    Bp, Tp, D = x_prompt.shape
    xp = jnp.concatenate(
        [jnp.broadcast_to(meta_tokens.astype(x_prompt.dtype)[None], (Bp, N_META, D)), x_prompt], axis=1)
    xs = x_sample
    zero_buf = jnp.zeros((Bp, POOL_BUF, POOL_WIDTH), x_prompt.dtype)
    zero_S = jnp.zeros((Bp, GLA_HEADS, GLA_DK, GLA_DV), jnp.float32)
    pool_p, gla_p, pool_s, gla_s = [], [], [], []
    for l in range(DEPTH):
        params = (g_mix[l], w_in[l], w_gk_up[l], b_gk[l], w_pool_group[l], pool_scale[l],
                  w_pool_proj[l], g_gla_norm[l], w_gla_proj[l], w_out[l], g_ffn[l],
                  w_ffn_in[l], w_ffn_out[l])
        xp, bp, sp = _layer(xp, zero_buf, zero_S, 0, (N_META, Tp), *params)
        xs, bs, ss = _layer(xs, state_pool[l], state_gla[l], PAST_LEN, (xs.shape[1],), *params)
        pool_p.append(bp)
        gla_p.append(sp)
        pool_s.append(bs)
        gla_s.append(ss)
    y_prompt = _rmsnorm(xp[:, N_META:], g_final)
    y_sample = _rmsnorm(xs, g_final)
    return (y_prompt, y_sample, jnp.stack(pool_p), jnp.stack(gla_p), jnp.stack(pool_s), jnp.stack(gla_s))
```

```cpp
#include <hip/hip_runtime.h>
#include <hip/hip_cooperative_groups.h>
#include <cstdio>
#include <cstdint>
namespace cg = cooperative_groups;
namespace pg8 {
#define PG8_LAS __attribute__((address_space(3)))
typedef unsigned short bf16_t;
typedef short bf16x8 __attribute__((ext_vector_type(8)));
typedef float f32x4 __attribute__((ext_vector_type(4)));
typedef unsigned u32x4 __attribute__((ext_vector_type(4)));
constexpr int BM = 256, BK = 64, HALF = 128, HTB = HALF * BK * 2  , STAGE_BYTES = 8 * HTB, NXCD = 8, WGM = 8;

__host__ __device__ __forceinline__ int lds_byte(int r, int c) { const int st = (r >> 4) * 2 + (c >> 5), rr = r & 15, cc = c & 31, ob = rr * 64 + cc * 2; return st * 1024 + (ob ^ (((ob >> 9) & 1) << 5)); }
__host__ __device__ __forceinline__ void stage_rc(int b, int& R, int& C) { const int st = b / 1024, sb = b % 1024, swz = sb ^ (((sb >> 9) & 1) << 5); R = (st >> 1) * 16 + swz / 64; C = (st & 1) * 32 + (swz % 64) / 2; }
__host__ __device__ __forceinline__ int perm32(int rho) { const int n = rho >> 4, i = rho & 15; return 8 * (i >> 2) + 4 * n + (i & 3); }

struct Unit { int pm, pn; };
struct Gemm { const bf16_t* A; const bf16_t* Bt; int M, N, K; };

struct StaticOrder {
    int nM, nN, nwg, G, c;
    __host__ __device__ void init(int M, int N, int G_, int c_) { nM = M / BM; nN = N / BM; nwg = nM * nN; G = G_; c = c_; }
    __host__ __device__ bool next(int i, Unit& u) const {
        const long L = (long)i * G + c; if (L >= nwg) return false;
        int wgid = (int)L; { const int q = nwg / NXCD, r = nwg % NXCD, xcd = wgid % NXCD, off = wgid / NXCD; wgid = (xcd < r ? xcd * (q + 1) : r * (q + 1) + (xcd - r) * q) + off; }
        const int nig = WGM * nN, gid = wgid / nig, fm = gid * WGM, gsz = (nM - fm) < WGM ? (nM - fm) : WGM;
        u.pm = fm + ((wgid % nig) % gsz); u.pn = (wgid % nig) / gsz; return true;
    }
    __device__ __forceinline__ void a_ready(const Unit&) const {}
    __device__ __forceinline__ void done(const Unit&) const {}
};

__device__ __forceinline__ unsigned cvt_pk_bf16(float lo, float hi) { unsigned r; asm volatile("v_cvt_pk_bf16_f32 %0, %1, %2" : "=v"(r) : "v"(lo), "v"(hi)); return r; }
typedef float f32x2 __attribute__((ext_vector_type(2)));
__device__ __forceinline__ f32x2 gelu_pk(f32x2 v) {
    const f32x2 av = __builtin_elementwise_abs(v), d = av * 0.2316418882f + 1.0f;
    f32x2 t; t.x = __builtin_amdgcn_rcpf(d.x); t.y = __builtin_amdgcn_rcpf(d.y);
    f32x2 q = t * 0.5307027145f + (-0.7265760135f); q = q * t + 0.7107068705f; q = q * t + (-0.142248368f); q = q * t + 0.127414796f; q = q * t;
    const f32x2 s = (v * v) * (-0.72134752044f);
    f32x2 e; e.x = __builtin_amdgcn_exp2f(s.x); e.y = __builtin_amdgcn_exp2f(s.y);
    const f32x2 m = v * (q * e), r = v - m;
    f32x2 o; o.x = v.x < 0.f ? m.x : r.x; o.y = v.y < 0.f ? m.y : r.y; return o;
}

template <int ACT  > struct EpiBf16 {
    static constexpr bool PERM = true, AFTER_DRAIN = false; static_assert(ACT == 0 || ACT == 1, "EpiBf16: ACT is 0 (none) or 1 (gelu_pk)");
    bf16_t* O; int ldc; const float* bias; int split_cols; size_t split_stride; float scale0;
    __device__ __forceinline__ void operator()(const f32x4 (&acc)[2][2][4][2], const Unit& u, int wr, int wc, int fr, int fq) const {
        const int row0 = u.pm * BM + wr * 64 + fr; int colt = u.pn * BM; bf16_t* base = O;
        float sc = 1.f; if (split_cols) { const int t = colt / split_cols; base += (size_t)t * split_stride; colt -= t * split_cols; if (t == 0) sc = scale0; }
        const int col0 = colt + wc * 32 + 8 * fq, bcol0 = u.pn * BM + wc * 32 + 8 * fq;
        f32x4 bv[2][2];
#pragma unroll
        for (int bj = 0; bj < 2; ++bj)
#pragma unroll
            for (int n = 0; n < 2; ++n) bv[bj][n] = bias ? *(const f32x4*)(bias + bcol0 + bj * HALF + 4 * n) : (f32x4){0.f, 0.f, 0.f, 0.f};
#pragma unroll
        for (int ai = 0; ai < 2; ++ai)
#pragma unroll
            for (int m = 0; m < 4; ++m) { bf16_t* rowp = base + (size_t)(row0 + ai * HALF + m * 16) * ldc + col0;
#pragma unroll
                for (int bj = 0; bj < 2; ++bj) { f32x4 v0 = acc[ai][bj][m][0] + bv[bj][0], v1 = acc[ai][bj][m][1] + bv[bj][1];
                    if (ACT == 1) { f32x2 a = gelu_pk((f32x2){v0[0], v0[1]}), b = gelu_pk((f32x2){v0[2], v0[3]}), c = gelu_pk((f32x2){v1[0], v1[1]}), d = gelu_pk((f32x2){v1[2], v1[3]});
                        v0 = (f32x4){a.x, a.y, b.x, b.y}; v1 = (f32x4){c.x, c.y, d.x, d.y}; }
                    v0 = v0 * sc; v1 = v1 * sc; u32x4 w; w.x = cvt_pk_bf16(v0[0], v0[1]); w.y = cvt_pk_bf16(v0[2], v0[3]); w.z = cvt_pk_bf16(v1[0], v1[1]); w.w = cvt_pk_bf16(v1[2], v1[3]);
                    *(u32x4*)(rowp + bj * HALF) = w; } }
    }
};
constexpr int R_META = 16384, R_SAMPLE = 16512, R_END = 17024, MP = 17152, DM = 1024, NMT = MP / 256;
constexpr float RMS_EPS = 1e-6f;
typedef unsigned u32x2 __attribute__((ext_vector_type(2)));
__device__ __forceinline__ float bflo(unsigned w) { return __uint_as_float(w << 16); }
__device__ __forceinline__ float bfhi(unsigned w) { return __uint_as_float(w & 0xffff0000u); }
__device__ __forceinline__ float bf2f(bf16_t h) { return __uint_as_float((unsigned)h << 16); }
__device__ __forceinline__ float sigm(float x) { return __builtin_amdgcn_rcpf(1.f + __expf(-x)); }
struct RowMap { const float* xp; const float* xs; const float* meta; float* out; float* xscr; };
__device__ __forceinline__ const float* xrow_ptr(const RowMap& R, int r) {
    if (r < R_META) return R.xp + (size_t)r * DM;
    if (r < R_SAMPLE) return R.meta + (size_t)((r - R_META) & 15) * DM;
    if (r < R_END) return R.xs + (size_t)(r - R_SAMPLE) * DM;
    return nullptr;
}
__device__ __forceinline__ float* orow_ptr(const RowMap& R, int r) {
    if (r < R_META) return R.out + (size_t)r * DM;
    if (r < R_SAMPLE) return R.xscr + (size_t)(r - R_META) * DM;
    if (r < R_END) return R.out + (size_t)(r - 128) * DM;
    return R.xscr + (size_t)(r - R_END + 128) * DM;
}

struct EpiMerge {
    static constexpr bool PERM = true, AFTER_DRAIN = false;
    const bf16_t* P; bf16_t* MG;
    __device__ __forceinline__ void operator()(const f32x4 (&acc)[2][2][4][2], const Unit& u, int wr, int wc, int fr, int fq) const {
        const int which = u.pm >= NMT ? 1 : 0; const int pm = u.pm - NMT * which, pn = u.pn - 4 * which;
        const int row0 = pm * BM + wr * 64 + fr, col0 = pn * BM + wc * 32 + 8 * fq;
        const bf16_t* gbase = P + 2048 + which * 1024;
#pragma unroll
        for (int ai = 0; ai < 2; ++ai)
#pragma unroll
            for (int m = 0; m < 4; ++m) { const size_t r = (size_t)(row0 + ai * HALF + m * 16);
#pragma unroll
                for (int bj = 0; bj < 2; ++bj) { const int c = col0 + bj * HALF;
                    const u32x4 gw = *(const u32x4*)(gbase + r * 4096 + c);
                    const f32x4 v0 = acc[ai][bj][m][0], v1 = acc[ai][bj][m][1];
                    float o0 = v0[0] * sigm(bflo(gw.x)), o1 = v0[1] * sigm(bfhi(gw.x)), o2 = v0[2] * sigm(bflo(gw.y)), o3 = v0[3] * sigm(bfhi(gw.y));
                    float o4 = v1[0] * sigm(bflo(gw.z)), o5 = v1[1] * sigm(bfhi(gw.z)), o6 = v1[2] * sigm(bflo(gw.w)), o7 = v1[3] * sigm(bfhi(gw.w));
                    bf16_t* dst = MG + r * 1024 + c;
                    if (which) { const u32x4 ow = *(const u32x4*)dst;
                        o0 += bflo(ow.x); o1 += bfhi(ow.x); o2 += bflo(ow.y); o3 += bfhi(ow.y); o4 += bflo(ow.z); o5 += bfhi(ow.z); o6 += bflo(ow.w); o7 += bfhi(ow.w); }
                    u32x4 w; w.x = cvt_pk_bf16(o0, o1); w.y = cvt_pk_bf16(o2, o3); w.z = cvt_pk_bf16(o4, o5); w.w = cvt_pk_bf16(o6, o7);
                    *(u32x4*)dst = w; } }
    }
};
struct EpiRes1 {
    static constexpr bool PERM = false, AFTER_DRAIN = false;
    RowMap R; bf16_t* X1B; float* SSP;
    __device__ __forceinline__ void operator()(const f32x4 (&acc)[2][2][4][2], const Unit& u, int wr, int wc, int fr, int fq) const {
        const int col0 = u.pn * BM + wc * 32 + 4 * fq;
#pragma unroll
        for (int ai = 0; ai < 2; ++ai)
#pragma unroll
            for (int m = 0; m < 4; ++m) { const int r = u.pm * BM + ai * HALF + wr * 64 + m * 16 + fr;
                const float* xr = xrow_ptr(R, r); float* orow = orow_ptr(R, r); float ss = 0.f;
#pragma unroll
                for (int bj = 0; bj < 2; ++bj)
#pragma unroll
                    for (int n = 0; n < 2; ++n) { const int c = col0 + bj * HALF + n * 16;
                        f32x4 v = acc[ai][bj][m][n]; if (xr) v += *(const f32x4*)(xr + c);
                        *(f32x4*)(orow + c) = v; ss += (v[0] * v[0] + v[1] * v[1]) + (v[2] * v[2] + v[3] * v[3]);
                        u32x2 w; w.x = cvt_pk_bf16(v[0], v[1]); w.y = cvt_pk_bf16(v[2], v[3]); *(u32x2*)(X1B + (size_t)r * DM + c) = w; }
                ss += __shfl_xor(ss, 16); ss += __shfl_xor(ss, 32);
                if (fq == 0) SSP[(size_t)r * 16 + u.pn * 4 + wc] = ss;
                if (m & 1) asm volatile("" ::: "memory"); }
    }
};
struct EpiSwiglu {
    static constexpr bool PERM = true, AFTER_DRAIN = false;
    const float* SSP; bf16_t* ACT; int ldact;
    __device__ __forceinline__ void operator()(const f32x4 (&acc)[2][2][4][2], const Unit& u, int wr, int wc, int fr, int fq) const {
        const int col0 = u.pn * HALF + wc * 32 + 8 * fq;
#pragma unroll
        for (int ai = 0; ai < 2; ++ai)
#pragma unroll
            for (int m = 0; m < 4; ++m) { const int r = u.pm * BM + ai * HALF + wr * 64 + m * 16 + fr;
                const f32x4* sp = (const f32x4*)(SSP + (size_t)r * 16); const f32x4 s0 = sp[0], s1 = sp[1], s2 = sp[2], s3 = sp[3];
                const float tot = (((s0[0] + s0[1]) + (s0[2] + s0[3])) + ((s1[0] + s1[1]) + (s1[2] + s1[3]))) + (((s2[0] + s2[1]) + (s2[2] + s2[3])) + ((s3[0] + s3[1]) + (s3[2] + s3[3])));
                const float rstd = rsqrtf(tot * (1.f / DM) + RMS_EPS);
                float o[8];
#pragma unroll
                for (int n = 0; n < 2; ++n)
#pragma unroll
                    for (int j = 0; j < 4; ++j) { const float g = acc[ai][0][m][n][j] * rstd, up = acc[ai][1][m][n][j] * rstd; o[n * 4 + j] = g * sigm(g) * up; }
                u32x4 w; w.x = cvt_pk_bf16(o[0], o[1]); w.y = cvt_pk_bf16(o[2], o[3]); w.z = cvt_pk_bf16(o[4], o[5]); w.w = cvt_pk_bf16(o[6], o[7]);
                *(u32x4*)(ACT + (size_t)r * ldact + col0) = w; }
    }
};
struct EpiRes2 {
    static constexpr bool PERM = false, AFTER_DRAIN = false;
    RowMap R; float* SSP;
    __device__ __forceinline__ void operator()(const f32x4 (&acc)[2][2][4][2], const Unit& u, int wr, int wc, int fr, int fq) const {
        const int col0 = u.pn * BM + wc * 32 + 4 * fq;
#pragma unroll
        for (int ai = 0; ai < 2; ++ai)
#pragma unroll
            for (int m = 0; m < 4; ++m) { const int r = u.pm * BM + ai * HALF + wr * 64 + m * 16 + fr;
                float* orow = orow_ptr(R, r); float ss = 0.f;
#pragma unroll
                for (int bj = 0; bj < 2; ++bj)
#pragma unroll
                    for (int n = 0; n < 2; ++n) { const int c = col0 + bj * HALF + n * 16;
                        const f32x4 v = acc[ai][bj][m][n] + *(const f32x4*)(orow + c);
                        *(f32x4*)(orow + c) = v; ss += (v[0] * v[0] + v[1] * v[1]) + (v[2] * v[2] + v[3] * v[3]); }
                ss += __shfl_xor(ss, 16); ss += __shfl_xor(ss, 32);
                if (fq == 0) SSP[(size_t)r * 16 + u.pn * 4 + wc] = ss;
                if (m & 1) asm volatile("" ::: "memory"); }
    }
};
struct PairOrder {
    StaticOrder base;
    __device__ void init(int G_, int c_) { base.init(MP, DM, G_, c_); }
    __device__ bool next(int i, Unit& u) const { if (!base.next(i >> 1, u)) return false; if (i & 1) { u.pm += NMT; u.pn += 4; } return true; }
    __device__ __forceinline__ void a_ready(const Unit&) const {}
    __device__ __forceinline__ void done(const Unit&) const {}
};
template <class Epi, class Sched, bool ALIGN_EPI = false, bool SP2 = false>
__device__ __forceinline__ void gemm_phase(PG8_LAS unsigned char* lds, const Gemm g, const Sched& S, const Epi& E) {
    const int tid = threadIdx.x, wid = __builtin_amdgcn_readfirstlane(tid >> 6), lane = tid & 63, wr = wid >> 2, wc = wid & 3, fr = lane & 15, fq = lane >> 4;
    const int K = g.K, nt = K / BK;
    unsigned voffA[2], voffB[2];
#pragma unroll
    for (int i = 0; i < 2; ++i) { int R, C; stage_rc(tid * 16 + i * 8192, R, C); const int Rb = Epi::PERM ? ((R & ~31) + perm32(R & 31)) : R;
        voffA[i] = (unsigned)(R * K + C) * 2u; voffB[i] = (unsigned)(Rb * K + C) * 2u; }
    const size_t kstep = (size_t)(BK * 2);
    const size_t hstep = (size_t)HALF * K * 2;
    const size_t tstep = 2 * hstep;
    const unsigned ldsw = (unsigned)wid * 1024u;
    const int aoff = lds_byte(wr * 64 + fr, fq * 8), boff = lds_byte(wc * 32 + fr, fq * 8);
#define PG8_SA(b, h) (((b) * 2 + (h)) * HTB)
#define PG8_SB(b, h) ((4 + (b) * 2 + (h)) * HTB)
#define PG8_STAGE(bufoff, gbase, voff) do { _Pragma("unroll") for (int _i = 0; _i < 2; ++_i) \
        __builtin_amdgcn_global_load_lds((const unsigned*)((const char*)(gbase) + (voff)[_i]), (PG8_LAS unsigned*)(lds + (bufoff) + ldsw + _i * 8192), 16, 0, 0); } while (0)
#define PG8_LDA(dst, b, h) do { _Pragma("unroll") for (int m = 0; m < 4; ++m) _Pragma("unroll") for (int k = 0; k < 2; ++k) dst[m][k] = *(const PG8_LAS bf16x8*)(lds + PG8_SA(b, h) + aoff + m * 2048 + k * 1024); } while (0)
#define PG8_LDB(dst, b, h) do { _Pragma("unroll") for (int n = 0; n < 2; ++n) _Pragma("unroll") for (int k = 0; k < 2; ++k) dst[n][k] = *(const PG8_LAS bf16x8*)(lds + PG8_SB(b, h) + boff + n * 2048 + k * 1024); } while (0)
#define PG8_MMA(ai, bj, At, Bt) do { __builtin_amdgcn_s_setprio(1); _Pragma("unroll") for (int m = 0; m < 4; ++m) _Pragma("unroll") for (int n = 0; n < 2; ++n) _Pragma("unroll") for (int k = 0; k < 2; ++k) \
        acc[ai][bj][m][n] = __builtin_amdgcn_mfma_f32_16x16x32_bf16(Bt[n][k], At[m][k], acc[ai][bj][m][n], 0, 0, 0); __builtin_amdgcn_s_setprio(0); } while (0)
#define PG8_WAIT_V(n) asm volatile("s_waitcnt vmcnt(" #n ")" ::: "memory")
#define PG8_WAIT_L(n) asm volatile("s_waitcnt lgkmcnt(" #n ")" ::: "memory")
#define PG8_BAR __builtin_amdgcn_s_barrier()
#define PG8_SCHED __builtin_amdgcn_sched_barrier(0)
    Unit cur, nxt; int ui = 0;
    if (!S.next(0, cur)) return;
    f32x4 acc[2][2][4][2];
#pragma unroll
    for (int a = 0; a < 2; ++a)
#pragma unroll
        for (int b = 0; b < 2; ++b)
#pragma unroll
            for (int m = 0; m < 4; ++m)
#pragma unroll
                for (int n = 0; n < 2; ++n) acc[a][b][m][n] = (f32x4){0.f, 0.f, 0.f, 0.f};
    bf16x8 At[4][2], B0[2][2], B1[2][2];
    const char* cA = (const char*)g.A + (size_t)cur.pm * tstep; const char* cB = (const char*)g.Bt + (size_t)cur.pn * tstep;
    S.a_ready(cur);
    if constexpr (SP2) {
        PG8_STAGE(PG8_SB(0, 0), cB, voffB); PG8_STAGE(PG8_SB(0, 1), cB + hstep, voffB); PG8_STAGE(PG8_SA(0, 0), cA, voffA); PG8_STAGE(PG8_SA(0, 1), cA + hstep, voffA);
        if (wr == 1) PG8_BAR;
        PG8_WAIT_V(2); PG8_BAR;
        PG8_STAGE(PG8_SB(1, 0), cB + kstep, voffB); PG8_STAGE(PG8_SA(1, 0), cA + kstep, voffA); PG8_STAGE(PG8_SB(1, 1), cB + hstep + kstep, voffB);
        PG8_WAIT_V(6); PG8_BAR;
    } else {
        PG8_STAGE(PG8_SB(0, 0), cB, voffB); PG8_STAGE(PG8_SA(0, 0), cA, voffA); PG8_STAGE(PG8_SB(0, 1), cB + hstep, voffB); PG8_STAGE(PG8_SA(0, 1), cA + hstep, voffA);
        if (wr == 1) PG8_BAR;
        PG8_WAIT_V(4); PG8_BAR;
        PG8_STAGE(PG8_SB(1, 0), cB + kstep, voffB); PG8_STAGE(PG8_SA(1, 0), cA + kstep, voffA); PG8_STAGE(PG8_SB(1, 1), cB + hstep + kstep, voffB);
        PG8_WAIT_V(6); PG8_BAR;
    }
    for (;;) {
        const bool has_next = S.next(ui + 1, nxt);
        const char* nA = has_next ? (const char*)g.A + (size_t)nxt.pm * tstep : cA; const char* nB = has_next ? (const char*)g.Bt + (size_t)nxt.pn * tstep : cB;
        for (int t = 0; t < nt; t += 2) {
            const bool last = (t == nt - 2);
            const char* a1 = cA + (size_t)(t + 1) * kstep;
            const char* a2 = last ? nA : cA + (size_t)(t + 2) * kstep; const char* b2 = last ? nB : cB + (size_t)(t + 2) * kstep;
            const char* a3 = a2 + kstep; const char* b3 = b2 + kstep;
            if (last && has_next) S.a_ready(nxt);
            if constexpr (SP2) {
            PG8_LDB(B0, 0, 0); PG8_LDB(B1, 0, 1); PG8_SCHED; PG8_LDA(At, 0, 0); PG8_STAGE(PG8_SA(1, 1), a1 + hstep, voffA);
            PG8_WAIT_V(8); PG8_WAIT_L(0); PG8_BAR; PG8_MMA(0, 0, At, B0); PG8_MMA(0, 1, At, B1); PG8_BAR; PG8_SCHED;
            PG8_LDA(At, 0, 1); PG8_STAGE(PG8_SB(0, 0), b2, voffB); PG8_STAGE(PG8_SB(0, 1), b2 + hstep, voffB); PG8_STAGE(PG8_SA(0, 0), a2, voffA);
            PG8_WAIT_V(8); PG8_WAIT_L(0); PG8_BAR; PG8_MMA(1, 0, At, B0); PG8_MMA(1, 1, At, B1); PG8_BAR; PG8_SCHED;
            PG8_LDB(B0, 1, 0); PG8_LDB(B1, 1, 1); PG8_SCHED; PG8_LDA(At, 1, 0); PG8_STAGE(PG8_SA(0, 1), a2 + hstep, voffA);
            PG8_WAIT_V(8); PG8_WAIT_L(0); PG8_BAR; PG8_MMA(0, 0, At, B0); PG8_MMA(0, 1, At, B1); PG8_BAR; PG8_SCHED;
            PG8_LDA(At, 1, 1); PG8_STAGE(PG8_SB(1, 0), b3, voffB); PG8_STAGE(PG8_SB(1, 1), b3 + hstep, voffB); PG8_STAGE(PG8_SA(1, 0), a3, voffA);
            PG8_WAIT_V(8); PG8_WAIT_L(0); PG8_BAR; PG8_MMA(1, 0, At, B0); PG8_MMA(1, 1, At, B1); PG8_BAR; PG8_SCHED;
            } else {
            PG8_LDB(B0, 0, 0); PG8_SCHED; PG8_LDA(At, 0, 0); PG8_STAGE(PG8_SA(1, 1), a1 + hstep, voffA);
            PG8_WAIT_L(8); PG8_BAR; PG8_WAIT_L(0); PG8_MMA(0, 0, At, B0); PG8_BAR; PG8_SCHED;
            PG8_LDB(B1, 0, 1); PG8_STAGE(PG8_SB(0, 0), b2, voffB);
            PG8_BAR; PG8_WAIT_L(0); PG8_MMA(0, 1, At, B1); PG8_BAR;
            PG8_LDA(At, 0, 1); PG8_STAGE(PG8_SA(0, 0), a2, voffA);
            PG8_BAR; PG8_WAIT_L(0); PG8_MMA(1, 0, At, B0); PG8_BAR; PG8_SCHED;
            PG8_STAGE(PG8_SB(0, 1), b2 + hstep, voffB);
            PG8_WAIT_V(6); PG8_BAR; PG8_MMA(1, 1, At, B1); PG8_BAR;
            PG8_LDB(B0, 1, 0); PG8_SCHED; PG8_LDA(At, 1, 0); PG8_STAGE(PG8_SA(0, 1), a2 + hstep, voffA);
            PG8_WAIT_L(8); PG8_BAR; PG8_WAIT_L(0); PG8_MMA(0, 0, At, B0); PG8_BAR; PG8_SCHED;
            PG8_LDB(B1, 1, 1); PG8_STAGE(PG8_SB(1, 0), b3, voffB);
            PG8_BAR; PG8_WAIT_L(0); PG8_MMA(0, 1, At, B1); PG8_BAR;
            PG8_LDA(At, 1, 1); PG8_STAGE(PG8_SA(1, 0), a3, voffA);
            PG8_BAR; PG8_WAIT_L(0); PG8_MMA(1, 0, At, B0); PG8_BAR; PG8_SCHED;
            PG8_STAGE(PG8_SB(1, 1), b3 + hstep, voffB);
            PG8_WAIT_V(6); PG8_BAR; PG8_MMA(1, 1, At, B1); PG8_BAR;
            }
        }
        if constexpr (ALIGN_EPI) { if (wr == 0) PG8_BAR; }
        if constexpr (!Epi::AFTER_DRAIN) { E(acc, cur, wr, wc, fr, fq); S.done(cur); }
        if (!has_next) break;
#pragma unroll
        for (int a = 0; a < 2; ++a)
#pragma unroll
            for (int b = 0; b < 2; ++b)
#pragma unroll
                for (int m = 0; m < 4; ++m)
#pragma unroll
                    for (int n = 0; n < 2; ++n) acc[a][b][m][n] = (f32x4){0.f, 0.f, 0.f, 0.f};
        cur = nxt; cA = nA; cB = nB; ++ui;
        if constexpr (ALIGN_EPI) { if (wr == 1) PG8_BAR; }
    }
    PG8_WAIT_V(0);
    if constexpr (!ALIGN_EPI) { if (wr == 0) PG8_BAR; }
    PG8_BAR;
    if constexpr (Epi::AFTER_DRAIN) { E.fused(acc, cur, wr, wc, fr, fq, lds, wid, lane); S.done(cur); }
#undef PG8_SA
#undef PG8_SB
#undef PG8_STAGE
#undef PG8_LDA
#undef PG8_LDB
#undef PG8_MMA
#undef PG8_WAIT_V
#undef PG8_WAIT_L
#undef PG8_BAR
#undef PG8_SCHED
}
}
#define LAS __attribute__((address_space(3)))
typedef unsigned short bf16;
typedef unsigned v4u __attribute__((ext_vector_type(4)));
typedef unsigned v2u __attribute__((ext_vector_type(2)));
typedef float f32x4 __attribute__((ext_vector_type(4)));
typedef short bf16x8 __attribute__((ext_vector_type(8)));
using pg8::R_META; using pg8::R_SAMPLE; using pg8::R_END; using pg8::MP; using pg8::DM; using pg8::NMT; using pg8::RMS_EPS;
using pg8::bf2f; using pg8::bflo; using pg8::bfhi; using pg8::sigm; using pg8::cvt_pk_bf16;
constexpr int NWAVES = 8, NTHREADS = 512;
constexpr int FF = 2816, NIN = 4096, INDIM = 4112, NBH = 32, NCH = 33, NITEM = NBH * NCH;
constexpr size_t MiB = 1u << 20;
constexpr size_t WS_WIN = 1 * MiB, WS_WCOMB = 9 * MiB, WS_WGP = 10 * MiB, WS_WOUT = 11 * MiB, WS_WFI = 13 * MiB, WS_WFO = 24 * MiB;
constexpr size_t WS_ZR = 30 * MiB;
constexpr size_t WS_XN = 32 * MiB;
constexpr size_t WS_P = 66 * MiB;
constexpr size_t WS_X1B = 160 * MiB;
constexpr size_t WS_QE = 200 * MiB, WS_KE = 209 * MiB;
constexpr size_t WS_POOLED = 218 * MiB, WS_OB = WS_POOLED + (size_t)MP * 512 * 2;
constexpr size_t WS_XS = 252 * MiB;
constexpr size_t WS_SSP1 = 253 * MiB, WS_SSP2 = 254 * MiB + MiB / 2;
constexpr size_t WS_END = 256 * MiB;
static_assert(WS_WCOMB + 1024 * 512 * 2 == WS_WGP && WS_OB + (size_t)MP * 512 * 2 <= WS_XS && WS_P + (size_t)MP * 2816 * 2 <= WS_X1B && WS_X1B + (size_t)MP * 1024 * 2 <= WS_QE, "ws map");
static_assert(WS_P + (size_t)MP * 4096 * 2 <= WS_QE && WS_XN + (size_t)MP * 1024 * 2 <= WS_P && WS_SSP1 + (size_t)MP * 64 <= WS_SSP2 && WS_SSP2 + (size_t)MP * 64 <= WS_END && WS_WFO + 1024 * 2816 * 2 <= WS_ZR, "ws map 2");
constexpr size_t O_YP = 0, O_YS = 16777216, O_PBP = 17301504, O_GSP = 17362944, O_PBS = 17625088, O_GSS = 18608128, O_TOTAL = 22802432;
constexpr size_t OS_UT = 0;
constexpr size_t OS_SINT = 40 * MiB / 4;
constexpr size_t OS_DD = 60 * MiB / 4;
static_assert((size_t)NITEM * 8192 <= OS_SINT && OS_SINT + (size_t)NITEM * 8192 / 2 <= OS_DD && OS_DD + NITEM * 64 <= O_YS, "d_out scratch");
constexpr int WAVE_LDS = 18432, LDS_BYTES = NWAVES * WAVE_LDS;
static_assert(LDS_BYTES >= pg8::STAGE_BYTES && LDS_BYTES >= 1024 * 80, "lds");

__device__ __forceinline__ unsigned f2bf(float f) { unsigned u = __builtin_bit_cast(unsigned, f); return (u + 0x7fffu + ((u >> 16) & 1u)) >> 16; }
__device__ __forceinline__ float wave_sum(float v) {
#pragma unroll
    for (int o = 1; o < 64; o <<= 1) v += __shfl_xor(v, o);
    return v;
}
__device__ __forceinline__ float logsig(float z) { return fminf(z, 0.f) - __logf(1.f + __expf(-fabsf(z))); }

struct Args { const float* in[19]; float* out; unsigned char* ws; };

__device__ __forceinline__ void tr_item(const float* W, int ldw, bf16* WT, int K, int k0, int nsrc0, int ndst0, const float* kscale, LAS float* scr, int lane) {
#pragma unroll 8
    for (int i = 0; i < 32; ++i) { const int kk = 2 * i + (lane >> 5); float v = W[(size_t)(k0 + kk) * ldw + nsrc0 + (lane & 31)]; if (kscale) v *= kscale[k0 + kk]; scr[kk * 33 + (lane & 31)] = v; }
    asm volatile("s_waitcnt lgkmcnt(0)" ::: "memory");
    const int c = lane & 7;
#pragma unroll
    for (int j = 0; j < 4; ++j) { const int n = (lane >> 3) + 8 * j; const LAS float* s = scr + (8 * c) * 33 + n;
        v4u o; o.x = cvt_pk_bf16(s[0 * 33], s[1 * 33]); o.y = cvt_pk_bf16(s[2 * 33], s[3 * 33]); o.z = cvt_pk_bf16(s[4 * 33], s[5 * 33]); o.w = cvt_pk_bf16(s[6 * 33], s[7 * 33]);
        *(v4u*)(WT + (size_t)(ndst0 + n) * K + k0 + 8 * c) = o; }
    asm volatile("s_waitcnt lgkmcnt(0)" ::: "memory");
}

struct GateCol { float w[16]; float bias; };
__device__ __forceinline__ float gate_logdecay(const GateCol& gc, const float* ZR, int row) {
    const f32x4* zp = (const f32x4*)(ZR + (size_t)row * 16); const f32x4 a = zp[0], b = zp[1], c = zp[2], d = zp[3];
    float z = gc.bias;
    z += a[0] * gc.w[0]; z += a[1] * gc.w[1]; z += a[2] * gc.w[2]; z += a[3] * gc.w[3];
    z += b[0] * gc.w[4]; z += b[1] * gc.w[5]; z += b[2] * gc.w[6]; z += b[3] * gc.w[7];
    z += c[0] * gc.w[8]; z += c[1] * gc.w[9]; z += c[2] * gc.w[10]; z += c[3] * gc.w[11];
    z += d[0] * gc.w[12]; z += d[1] * gc.w[13]; z += d[2] * gc.w[14]; z += d[3] * gc.w[15];
    return logsig(z) * (1.f / 16.f);
}

__device__ __forceinline__ void gla_a_item(int it, LAS unsigned char* wl, int lane, const bf16* P, const float* ZR, const float* w_gk_up, const float* b_gk,
                                           bf16* QE, bf16* KE, float* UT, float* DDp) {
    const int vh = it & 1, item = it >> 1, c = item % NCH, bh = item / NCH, b = bh >> 2, h = bh & 3;
    const int base = c == 0 ? R_META + b * 16 : b * 2048 + (c - 1) * 64, ntok = c == 0 ? 16 : 64;
    LAS unsigned char* kdt = wl; LAS unsigned char* vs = wl + 9216;
#pragma unroll
    for (int i = 0; i < 8; ++i) { const int row = (lane >> 3) + 8 * i, ch = lane & 7; v4u val = (v4u){0u, 0u, 0u, 0u};
        if (row < ntok) val = *(const v4u*)(P + (size_t)(base + row) * NIN + 1024 + h * 128 + vh * 64 + ch * 8);
        *(LAS v4u*)(vs + row * 144 + ch * 16) = val; }
    GateCol gc;
#pragma unroll
    for (int r = 0; r < 16; ++r) gc.w[r] = w_gk_up[r * 256 + h * 64 + lane];
    gc.bias = b_gk[h * 64 + lane];
    float blast = 0.f;
    for (int j = 0; j < ntok; ++j) blast += gate_logdecay(gc, ZR, base + j);
    float bc = 0.f;
    for (int j0 = 0; j0 < 64; j0 += 8) {
        unsigned pk[4];
#pragma unroll
        for (int jj = 0; jj < 8; jj += 2) { float kd2[2];
#pragma unroll
            for (int t = 0; t < 2; ++t) { const int j = j0 + jj + t; float kdv = 0.f;
                if (j < ntok) { bc += gate_logdecay(gc, ZR, base + j);
                    const float qv = bf2f(P[(size_t)(base + j) * NIN + 512 + h * 64 + lane]), kv = bf2f(P[(size_t)(base + j) * NIN + 768 + h * 64 + lane]);
                    kdv = kv * __expf(blast - bc);
                    if (vh == 0) QE[(size_t)(base + j) * 256 + h * 64 + lane] = (bf16)f2bf(qv * 0.125f * __expf(bc));
                    else KE[(size_t)(base + j) * 256 + h * 64 + lane] = (bf16)f2bf(kv * __expf(-bc)); }
                kd2[t] = kdv; }
            pk[jj >> 1] = cvt_pk_bf16(kd2[0], kd2[1]); }
        *(LAS v4u*)(kdt + lane * 144 + j0 * 2) = (v4u){pk[0], pk[1], pk[2], pk[3]};
    }
    if (vh == 0) DDp[item * 64 + lane] = __expf(blast);
    const int n = lane & 15, quad = lane >> 4;
    bf16x8 bv[2][4];
#pragma unroll
    for (int p = 0; p < 2; ++p)
#pragma unroll
        for (int vt = 0; vt < 4; ++vt) {
#pragma unroll
            for (int e = 0; e < 8; ++e) bv[p][vt][e] = (short)*(const LAS unsigned short*)(vs + (p * 32 + quad * 8 + e) * 144 + (vt * 16 + n) * 2); }
#pragma unroll
    for (int kt = 0; kt < 4; ++kt) {
        const bf16x8 a0 = *(const LAS bf16x8*)(kdt + (kt * 16 + n) * 144 + (quad * 8) * 2), a1 = *(const LAS bf16x8*)(kdt + (kt * 16 + n) * 144 + (32 + quad * 8) * 2);
#pragma unroll
        for (int vt = 0; vt < 4; ++vt) { f32x4 acc = (f32x4){0.f, 0.f, 0.f, 0.f};
            acc = __builtin_amdgcn_mfma_f32_16x16x32_bf16(a0, bv[0][vt], acc, 0, 0, 0); acc = __builtin_amdgcn_mfma_f32_16x16x32_bf16(a1, bv[1][vt], acc, 0, 0, 0);
            const int v = vh * 64 + vt * 16 + n;
            *(f32x4*)(UT + ((size_t)item * 128 + v) * 64 + kt * 16 + quad * 4) = acc; }
    }
    asm volatile("s_waitcnt lgkmcnt(0)" ::: "memory");
}

__device__ __forceinline__ void gla_sample_item(int it, LAS unsigned char* wl, int lane, const bf16* P, const float* ZR, const float* w_gk_up, const float* b_gk,
                                                const float* state_in, float* state_out, const float* g_gla_norm, bf16* OB) {
    const int sb = it >> 2, h = it & 3, base = R_SAMPLE + sb * 4;
    LAS float* qs = (LAS float*)wl; LAS float* ks = qs + 256; LAS float* ds = ks + 256;
    GateCol gc;
#pragma unroll
    for (int r = 0; r < 16; ++r) gc.w[r] = w_gk_up[r * 256 + h * 64 + lane];
    gc.bias = b_gk[h * 64 + lane];
    float bcum[4], qv[4], kv[4]; float bc = 0.f;
#pragma unroll
    for (int j = 0; j < 4; ++j) { bc += gate_logdecay(gc, ZR, base + j); bcum[j] = bc;
        qv[j] = bf2f(P[(size_t)(base + j) * NIN + 512 + h * 64 + lane]); kv[j] = bf2f(P[(size_t)(base + j) * NIN + 768 + h * 64 + lane]); }
    float qe[4], ke[4];
#pragma unroll
    for (int j = 0; j < 4; ++j) { qe[j] = qv[j] * 0.125f * __expf(bcum[j]); ke[j] = kv[j] * __expf(-bcum[j]);
        qs[j * 64 + lane] = qe[j]; ks[j * 64 + lane] = kv[j] * __expf(bcum[3] - bcum[j]); }
    ds[lane] = __expf(bcum[3]);
    float att[4][4];
#pragma unroll
    for (int i = 0; i < 4; ++i)
#pragma unroll
        for (int j = 0; j < 4; ++j) att[i][j] = (j <= i) ? wave_sum(qe[i] * ke[j]) : 0.f;
    asm volatile("s_waitcnt lgkmcnt(0)" ::: "memory");
    float vv[4][2];
#pragma unroll
    for (int j = 0; j < 4; ++j) { vv[j][0] = bf2f(P[(size_t)(base + j) * NIN + 1024 + h * 128 + lane]); vv[j][1] = bf2f(P[(size_t)(base + j) * NIN + 1024 + h * 128 + 64 + lane]); }
    float o[4][2];
#pragma unroll
    for (int i = 0; i < 4; ++i) { o[i][0] = 0.f; o[i][1] = 0.f; }
    const float* sin_ = state_in + (size_t)it * 8192; float* sout = state_out + (size_t)it * 8192;
#pragma unroll 4
    for (int kd = 0; kd < 64; ++kd) {
        const float s0 = sin_[kd * 128 + lane], s1 = sin_[kd * 128 + 64 + lane];
        const float dk = ds[kd];
        float n0 = dk * s0, n1 = dk * s1;
#pragma unroll
        for (int i = 0; i < 4; ++i) { const float q = qs[i * 64 + kd], k = ks[i * 64 + kd]; o[i][0] += q * s0; o[i][1] += q * s1; n0 += k * vv[i][0]; n1 += k * vv[i][1]; }
        sout[kd * 128 + lane] = n0; sout[kd * 128 + 64 + lane] = n1;
    }
    const float gn0 = g_gla_norm[lane], gn1 = g_gla_norm[64 + lane];
#pragma unroll
    for (int i = 0; i < 4; ++i) {
#pragma unroll
        for (int j = 0; j < 4; ++j) if (j <= i) { o[i][0] += att[i][j] * vv[j][0]; o[i][1] += att[i][j] * vv[j][1]; }
        const float ss = wave_sum(o[i][0] * o[i][0] + o[i][1] * o[i][1]); const float rstd = rsqrtf(ss * (1.f / 128.f) + RMS_EPS);
        const float g0 = bf2f(P[(size_t)(base + i) * NIN + 1536 + h * 128 + lane]), g1 = bf2f(P[(size_t)(base + i) * NIN + 1536 + h * 128 + 64 + lane]);
        OB[(size_t)(base + i) * 512 + h * 128 + lane] = (bf16)f2bf(o[i][0] * rstd * gn0 * g0 * sigm(g0));
        OB[(size_t)(base + i) * 512 + h * 128 + 64 + lane] = (bf16)f2bf(o[i][1] * rstd * gn1 * g1 * sigm(g1));
    }
    asm volatile("s_waitcnt lgkmcnt(0)" ::: "memory");
}

__device__ __forceinline__ void ld8(const bf16* p, float (&v)[8]) { const v4u w = *(const v4u*)p; v[0] = bflo(w.x); v[1] = bfhi(w.x); v[2] = bflo(w.y); v[3] = bfhi(w.y); v[4] = bflo(w.z); v[5] = bfhi(w.z); v[6] = bflo(w.w); v[7] = bfhi(w.w); }
__device__ __forceinline__ void ld8f(const float* p, float (&v)[8]) { const f32x4 a = *(const f32x4*)p, b = *(const f32x4*)(p + 4); v[0] = a[0]; v[1] = a[1]; v[2] = a[2]; v[3] = a[3]; v[4] = b[0]; v[5] = b[1]; v[6] = b[2]; v[7] = b[3]; }
__device__ __forceinline__ void st8f(float* p, const float (&v)[8]) { *(f32x4*)p = (f32x4){v[0], v[1], v[2], v[3]}; *(f32x4*)(p + 4) = (f32x4){v[4], v[5], v[6], v[7]}; }
__device__ __forceinline__ void pool_item(int r, int lane, const bf16* P, const float* state_pool, bf16* POOLED, bf16* OB, float* out) {
    const int c0 = lane * 8, w = 2 << (lane >> 4);
    if (r >= R_END) { *(v4u*)(POOLED + (size_t)r * 512 + c0) = (v4u){0u, 0u, 0u, 0u}; *(v4u*)(OB + (size_t)r * 512 + c0) = (v4u){0u, 0u, 0u, 0u}; return; }
    float u[8], s[8]; ld8(P + (size_t)r * NIN + c0, u);
#pragma unroll
    for (int e = 0; e < 8; ++e) s[e] = u[e];
    float cnt = (float)w;
    if (r < R_META) { const int b = r >> 11, t = r & 2047;
        for (int d = 1; d < 16; ++d) if (d < w) { const int tp = t - d; const int row = tp >= 0 ? b * 2048 + tp : R_META + b * 16 + 16 + tp; float x[8]; ld8(P + (size_t)row * NIN + c0, x);
#pragma unroll
            for (int e = 0; e < 8; ++e) s[e] += x[e]; }
        if (t >= 2033) st8f(out + O_PBP + ((size_t)(b * 15 + (t - 2033))) * 512 + c0, u);
    } else if (r < R_SAMPLE) { const int b = (r - R_META) >> 4, i = (r - R_META) & 15;
        for (int d = 1; d < 16; ++d) if (d < w && i - d >= 0) { float x[8]; ld8(P + (size_t)(r - d) * NIN + c0, x);
#pragma unroll
            for (int e = 0; e < 8; ++e) s[e] += x[e]; }
        cnt = (float)(w < i + 1 ? w : i + 1);
    } else { const int sb = (r - R_SAMPLE) >> 2, st = (r - R_SAMPLE) & 3;
        for (int d = 1; d < 16; ++d) if (d < w) { const int tp = st - d; float x[8];
            if (tp >= 0) ld8(P + (size_t)(r - d) * NIN + c0, x); else ld8f(state_pool + ((size_t)sb * 15 + 15 + tp) * 512 + c0, x);
#pragma unroll
            for (int e = 0; e < 8; ++e) s[e] += x[e]; }
        st8f(out + O_PBS + ((size_t)sb * 15 + 11 + st) * 512 + c0, u);
        if (st == 0) for (int k = 0; k < 11; ++k) { float x[8]; ld8f(state_pool + ((size_t)sb * 15 + 4 + k) * 512 + c0, x); st8f(out + O_PBS + ((size_t)sb * 15 + k) * 512 + c0, x); }
    }
    const float inv = 1.f / cnt;
    v4u o; o.x = cvt_pk_bf16(s[0] * inv - u[0], s[1] * inv - u[1]); o.y = cvt_pk_bf16(s[2] * inv - u[2], s[3] * inv - u[3]);
    o.z = cvt_pk_bf16(s[4] * inv - u[4], s[5] * inv - u[5]); o.w = cvt_pk_bf16(s[6] * inv - u[6], s[7] * inv - u[7]);
    *(v4u*)(POOLED + (size_t)r * 512 + c0) = o;
}

template <int IH>
__device__ __forceinline__ void gla_c_item(int item, LAS unsigned char* wl, int lane, const bf16* P, const bf16* QE, const bf16* KE, const bf16* SINT, const float* g_gla_norm, bf16* OB) {
    const int c = item % NCH, bh = item / NCH, b = bh >> 2, h = bh & 3;
    const int base = c == 0 ? R_META + b * 16 : b * 2048 + (c - 1) * 64, ntok = c == 0 ? 16 : 64;
    const int n = lane & 15, quad = lane >> 4;
#pragma unroll
    for (int i = 0; i < 16; ++i) { const int row = (lane >> 4) + 4 * i, ch = lane & 15; v4u val = (v4u){0u, 0u, 0u, 0u};
        if (row < ntok) val = *(const v4u*)(P + (size_t)(base + row) * NIN + 1024 + h * 128 + ch * 8);
        *(LAS v4u*)(wl + row * 272 + ch * 16) = val; }
    bf16x8 qf[2][2];
#pragma unroll
    for (int li = 0; li < 2; ++li)
#pragma unroll
        for (int p = 0; p < 2; ++p) qf[li][p] = *(const bf16x8*)(QE + (size_t)(base + (2 * IH + li) * 16 + n) * 256 + h * 64 + p * 32 + quad * 8);
    constexpr int NJT = 2 * IH + 2;
    bf16x8 kf[NJT][2];
#pragma unroll
    for (int jt = 0; jt < NJT; ++jt)
#pragma unroll
        for (int p = 0; p < 2; ++p) kf[jt][p] = *(const bf16x8*)(KE + (size_t)(base + jt * 16 + n) * 256 + h * 64 + p * 32 + quad * 8);
    v4u af[2][IH + 1];
#pragma unroll
    for (int li = 0; li < 2; ++li) { const int itile = 2 * IH + li;
        f32x4 t[2 * IH + 2];
#pragma unroll
        for (int jt = 0; jt < 2 * IH + 2; ++jt) { f32x4 s = (f32x4){0.f, 0.f, 0.f, 0.f};
            if (jt <= itile) { s = __builtin_amdgcn_mfma_f32_16x16x32_bf16(kf[jt][0], qf[li][0], s, 0, 0, 0); s = __builtin_amdgcn_mfma_f32_16x16x32_bf16(kf[jt][1], qf[li][1], s, 0, 0, 0);
                if (jt == itile) {
#pragma unroll
                    for (int jj = 0; jj < 4; ++jj) if (quad * 4 + jj > n) s[jj] = 0.f; } }
            t[jt] = s; }
#pragma unroll
        for (int p = 0; p <= IH; ++p) { v4u a; a.x = cvt_pk_bf16(t[2 * p][0], t[2 * p][1]); a.y = cvt_pk_bf16(t[2 * p][2], t[2 * p][3]); a.z = cvt_pk_bf16(t[2 * p + 1][0], t[2 * p + 1][1]); a.w = cvt_pk_bf16(t[2 * p + 1][2], t[2 * p + 1][3]); af[li][p] = a; }
    }
    f32x4 acc[2][8];
#pragma unroll
    for (int li = 0; li < 2; ++li)
#pragma unroll
        for (int vt = 0; vt < 8; ++vt) acc[li][vt] = (f32x4){0.f, 0.f, 0.f, 0.f};
#pragma unroll
    for (int p = 0; p <= IH; ++p)
#pragma unroll
        for (int vt = 0; vt < 8; ++vt) { bf16x8 bvf;
#pragma unroll
            for (int e = 0; e < 8; ++e) { const int j = 32 * p + (e >> 2) * 16 + quad * 4 + (e & 3); bvf[e] = (short)*(const LAS unsigned short*)(wl + j * 272 + (vt * 16 + n) * 2); }
#pragma unroll
            for (int li = 0; li < 2; ++li) acc[li][vt] = __builtin_amdgcn_mfma_f32_16x16x32_bf16(__builtin_bit_cast(bf16x8, af[li][p]), bvf, acc[li][vt], 0, 0, 0); }
#pragma unroll
    for (int p = 0; p < 2; ++p)
#pragma unroll
        for (int vt = 0; vt < 8; ++vt) { const bf16x8 sf = *(const bf16x8*)(SINT + ((size_t)item * 128 + vt * 16 + n) * 64 + p * 32 + quad * 8);
#pragma unroll
            for (int li = 0; li < 2; ++li) acc[li][vt] = __builtin_amdgcn_mfma_f32_16x16x32_bf16(qf[li][p], sf, acc[li][vt], 0, 0, 0); }
#pragma unroll
    for (int li = 0; li < 2; ++li) { float ss[4] = {0.f, 0.f, 0.f, 0.f};
#pragma unroll
        for (int vt = 0; vt < 8; ++vt)
#pragma unroll
            for (int jj = 0; jj < 4; ++jj) ss[jj] += acc[li][vt][jj] * acc[li][vt][jj];
#pragma unroll
        for (int jj = 0; jj < 4; ++jj) { float s = ss[jj]; s += __shfl_xor(s, 1); s += __shfl_xor(s, 2); s += __shfl_xor(s, 4); s += __shfl_xor(s, 8);
            const float rstd = rsqrtf(s * (1.f / 128.f) + RMS_EPS); const int il = (2 * IH + li) * 16 + quad * 4 + jj;
            if (il < ntok) { const size_t row = (size_t)(base + il);
#pragma unroll
                for (int vt = 0; vt < 8; ++vt) { const int v = vt * 16 + n; const float og = bf2f(P[row * NIN + 1536 + h * 128 + v]);
                    OB[row * 512 + h * 128 + v] = (bf16)f2bf(acc[li][vt][jj] * rstd * g_gla_norm[v] * og * sigm(og)); } } }
    }
    asm volatile("s_waitcnt lgkmcnt(0)" ::: "memory");
}

__global__ void __launch_bounds__(NTHREADS, 2) mega_fwd(Args args) {
    extern __shared__ __attribute__((aligned(16))) unsigned char lds_raw[];
    LAS unsigned char* lds = (LAS unsigned char*)lds_raw;
    cg::grid_group grid = cg::this_grid();
    const int tid = threadIdx.x, lane = tid & 63, wave = __builtin_amdgcn_readfirstlane(tid >> 6);
    const int G = gridDim.x, gw = blockIdx.x * NWAVES + wave, NGW = G * NWAVES;
    LAS unsigned char* wl = lds + wave * WAVE_LDS;
    unsigned char* ws = args.ws; float* out = args.out;
    const float *x_prompt = args.in[0], *x_sample = args.in[1], *state_pool = args.in[2], *state_gla = args.in[3], *meta_tokens = args.in[4], *g_mix = args.in[5], *w_in = args.in[6], *w_gk_up = args.in[7], *b_gk = args.in[8],
                *w_pool_group = args.in[9], *pool_scale = args.in[10], *w_pool_proj = args.in[11], *g_gla_norm = args.in[12], *w_gla_proj = args.in[13], *w_out = args.in[14], *g_ffn = args.in[15], *w_ffn_in = args.in[16],
                *w_ffn_out = args.in[17], *g_final = args.in[18];
    bf16 *WinT = (bf16*)(ws + WS_WIN), *WcombT = (bf16*)(ws + WS_WCOMB), *WgpT = (bf16*)(ws + WS_WGP), *WoutT = (bf16*)(ws + WS_WOUT), *WfiT = (bf16*)(ws + WS_WFI), *WfoT = (bf16*)(ws + WS_WFO);
    float* ZR = (float*)(ws + WS_ZR); bf16* XN = (bf16*)(ws + WS_XN); bf16* MG = XN; bf16* P = (bf16*)(ws + WS_P); bf16* ACT = P; bf16* X1B = (bf16*)(ws + WS_X1B);
    bf16 *QE = (bf16*)(ws + WS_QE), *KE = (bf16*)(ws + WS_KE), *POOLED = (bf16*)(ws + WS_POOLED), *OB = (bf16*)(ws + WS_OB);
    float *XS = (float*)(ws + WS_XS), *SSP1 = (float*)(ws + WS_SSP1), *SSP2 = (float*)(ws + WS_SSP2);
    float* UT = out + OS_UT; bf16* SINT = (bf16*)(out + OS_SINT); float* DDp = out + OS_DD;
    const pg8::RowMap RM{x_prompt, x_sample, meta_tokens, out, XS};
#define GRID_SYNC() grid.sync()

    {
        LAS float* scr = (LAS float*)wl;
        constexpr int I_IN = 16 * 128, I_GP = 8 * 32, I_OUT = 16 * 32, I_FI = 16 * 176, I_FO = 44 * 32, I_ALL = I_IN + I_GP + I_OUT + I_FI + I_FO;
        for (int it = gw; it < I_ALL; it += NGW) {
            int r = it;
            if (r < I_IN) { const int kb = r / 128, n0 = (r % 128) * 32; tr_item(w_in, INDIM, WinT, 1024, kb * 64, n0 + (n0 >= 2048 ? 16 : 0), n0, nullptr, scr, lane); continue; } r -= I_IN;
            if (r < I_GP) { const int kb = r / 32, n0 = (r % 32) * 32; tr_item(w_gla_proj, 1024, WgpT, 512, kb * 64, n0, n0, nullptr, scr, lane); continue; } r -= I_GP;
            if (r < I_OUT) { const int kb = r / 32, n0 = (r % 32) * 32; tr_item(w_out, 1024, WoutT, 1024, kb * 64, n0, n0, nullptr, scr, lane); continue; } r -= I_OUT;
            if (r < I_FI) { const int kb = r / 176, n0 = (r % 176) * 32; const int pn = n0 >> 8, wi = n0 & 255; const int src = wi < 128 ? 128 * pn + wi : FF + 128 * pn + (wi - 128);
                tr_item(w_ffn_in, 2 * FF, WfiT, 1024, kb * 64, src, n0, g_ffn, scr, lane); continue; } r -= I_FI;
            { const int kb = r / 32, n0 = (r % 32) * 32; tr_item(w_ffn_out, 1024, WfoT, FF, kb * 64, n0, n0, nullptr, scr, lane); }
        }
        for (int idx = blockIdx.x * NTHREADS + tid; idx < 512 * 1024; idx += G * NTHREADS) {
            const int gk = idx >> 10, n = idx & 1023, g = gk >> 7;
            const float* wg = w_pool_group + (size_t)gk * 128; const float* sc = pool_scale + g * 128; const float* wp = w_pool_proj + (size_t)(g * 128) * 1024 + n;
            float a = 0.f;
#pragma unroll 8
            for (int d = 0; d < 128; ++d) a += wg[d] * sc[d] * wp[(size_t)d * 1024];
            WcombT[(size_t)n * 512 + gk] = (bf16)f2bf(a);
        }
        __syncthreads();
        for (int idx = tid; idx < 1024 * 16; idx += NTHREADS) { const int k = idx >> 4, o = idx & 15; *(LAS float*)(lds + k * 80 + o * 4) = w_in[(size_t)k * INDIM + 2048 + o]; }
        __syncthreads();
        float gm[16];
#pragma unroll
        for (int i = 0; i < 16; ++i) gm[i] = g_mix[lane + 64 * i];
        for (int r = gw; r < MP; r += NGW) {
            const float* xr = pg8::xrow_ptr(RM, r);
            if (!xr) {
#pragma unroll
                for (int i = 0; i < 16; ++i) XN[(size_t)r * DM + lane + 64 * i] = 0;
                if (lane < 16) ZR[(size_t)r * 16 + lane] = 0.f;
                continue; }
            float x[16]; float ss = 0.f;
#pragma unroll
            for (int i = 0; i < 16; ++i) { x[i] = xr[lane + 64 * i]; ss += x[i] * x[i]; }
            const float rstd = rsqrtf(wave_sum(ss) * (1.f / DM) + RMS_EPS);
            f32x4 z0 = (f32x4){0.f, 0.f, 0.f, 0.f}, z1 = z0, z2 = z0, z3 = z0;
#pragma unroll
            for (int i = 0; i < 16; ++i) { const float hv = x[i] * rstd * gm[i]; XN[(size_t)r * DM + lane + 64 * i] = (bf16)f2bf(hv);
                const LAS f32x4* wz = (const LAS f32x4*)(lds + (lane + 64 * i) * 80);
                z0 += hv * wz[0]; z1 += hv * wz[1]; z2 += hv * wz[2]; z3 += hv * wz[3]; }
            float zv = 0.f;
#pragma unroll
            for (int o = 0; o < 4; ++o) { const float a = wave_sum(z0[o]), b = wave_sum(z1[o]), c = wave_sum(z2[o]), d = wave_sum(z3[o]);
                zv = lane == o ? a : zv; zv = lane == 4 + o ? b : zv; zv = lane == 8 + o ? c : zv; zv = lane == 12 + o ? d : zv; }
            if (lane < 16) ZR[(size_t)r * 16 + lane] = zv;
        }
    }
    GRID_SYNC();
    {
        pg8::Gemm g{XN, WinT, MP, NIN, 1024}; pg8::StaticOrder S; S.init(MP, NIN, G, (int)blockIdx.x);
        pg8::EpiBf16<0> E{P, NIN, nullptr, 0, 0, 1.f};
        pg8::gemm_phase<pg8::EpiBf16<0>, pg8::StaticOrder, true, true>(lds, g, S, E);
    }
    GRID_SYNC();
    {
        constexpr int N_A = 2 * NITEM, N_S = 512, N_ALL = N_A + N_S + MP;
        for (int it = gw; it < N_ALL; it += NGW) {
            if (it < N_A) gla_a_item(it, wl, lane, P, ZR, w_gk_up, b_gk, QE, KE, UT, DDp);
            else if (it < N_A + N_S) gla_sample_item(it - N_A, wl, lane, P, ZR, w_gk_up, b_gk, state_gla, out + O_GSS, g_gla_norm, OB);
            else pool_item(it - N_A - N_S, lane, P, state_pool, POOLED, OB, out);
        }
    }
    GRID_SYNC();
    for (int e = blockIdx.x * NTHREADS + tid; e < NBH * 8192; e += G * NTHREADS) {
        const int bh = e >> 13, rem = e & 8191, v = rem >> 6, kd = rem & 63;
        float S = 0.f;
#pragma unroll 11
        for (int c = 0; c < NCH; ++c) { const size_t item = (size_t)bh * NCH + c;
            SINT[(item * 128 + v) * 64 + kd] = (bf16)f2bf(S);
            S = DDp[item * 64 + kd] * S + UT[(item * 128 + v) * 64 + kd]; }
        out[O_GSP + ((size_t)bh * 64 + kd) * 128 + v] = S;
    }
    GRID_SYNC();
    {
        constexpr int N_C = 2 * NITEM;
        for (int it = gw; it < N_C; it += NGW) { const int item = it >> 1;
            if ((it & 1) == 0) gla_c_item<0>(item, wl, lane, P, QE, KE, SINT, g_gla_norm, OB);
            else if (item % NCH != 0) gla_c_item<1>(item, wl, lane, P, QE, KE, SINT, g_gla_norm, OB); }
    }
    GRID_SYNC();
    {
        pg8::Gemm g{POOLED, WcombT, 2 * MP, 2048, 512}; pg8::PairOrder S; S.init(G, (int)blockIdx.x);
        pg8::EpiMerge E{P, MG};
        pg8::gemm_phase<pg8::EpiMerge, pg8::PairOrder, true, true>(lds, g, S, E);
    }
    GRID_SYNC();
    {
        pg8::Gemm g{MG, WoutT, MP, DM, 1024}; pg8::StaticOrder S; S.init(MP, DM, G, (int)blockIdx.x);
        pg8::EpiRes1 E{RM, X1B, SSP1};
        pg8::gemm_phase<pg8::EpiRes1, pg8::StaticOrder, true, true>(lds, g, S, E);
    }
    GRID_SYNC();
    {
        pg8::Gemm g{X1B, WfiT, MP, 2 * FF, 1024}; pg8::StaticOrder S; S.init(MP, 2 * FF, G, (int)blockIdx.x);
        pg8::EpiSwiglu E{SSP1, ACT, FF};
        pg8::gemm_phase<pg8::EpiSwiglu, pg8::StaticOrder, true, true>(lds, g, S, E);
    }
    GRID_SYNC();
    {
        pg8::Gemm g{ACT, WfoT, MP, DM, FF}; pg8::StaticOrder S; S.init(MP, DM, G, (int)blockIdx.x);
        pg8::EpiRes2 E{RM, SSP2};
        pg8::gemm_phase<pg8::EpiRes2, pg8::StaticOrder, true, true>(lds, g, S, E);
    }
    GRID_SYNC();
    {
        f32x4 gf[4];
#pragma unroll
        for (int j = 0; j < 4; ++j) gf[j] = *(const f32x4*)(g_final + 4 * lane + 256 * j);
        for (int q = gw; q < R_META + 512; q += NGW) { const int r = q < R_META ? q : q + 128;
            float* orow = pg8::orow_ptr(RM, r);
            const f32x4* sp = (const f32x4*)(SSP2 + (size_t)r * 16); const f32x4 s0 = sp[0], s1 = sp[1], s2 = sp[2], s3 = sp[3];
            const float tot = (((s0[0] + s0[1]) + (s0[2] + s0[3])) + ((s1[0] + s1[1]) + (s1[2] + s1[3]))) + (((s2[0] + s2[1]) + (s2[2] + s2[3])) + ((s3[0] + s3[1]) + (s3[2] + s3[3])));
            const float rstd = rsqrtf(tot * (1.f / DM) + RMS_EPS);
#pragma unroll
            for (int j = 0; j < 4; ++j) { f32x4* p = (f32x4*)(orow + 4 * lane + 256 * j); *p = *p * rstd * gf[j]; }
        }
    }
}

extern "C" void kernel_launch(void* const* d_in, const int* in_sizes, int n_in, void* d_out, int out_size, void* d_ws, size_t ws_size, hipStream_t stream) {
    static int grid = 0;
    if (grid == 0) {
        if (n_in != 19 || (size_t)out_size != O_TOTAL || ws_size < WS_END) { fprintf(stderr, "kernel_launch: unexpected shapes (n_in %d out %d ws %zu)\n", n_in, out_size, ws_size); grid = -1; return; }
        int dev = 0, cus = 0, per_cu = 0;
        if (hipGetDevice(&dev) != hipSuccess || hipDeviceGetAttribute(&cus, hipDeviceAttributeMultiprocessorCount, dev) != hipSuccess) { grid = -1; return; }
        if (hipFuncSetAttribute((const void*)mega_fwd, hipFuncAttributeMaxDynamicSharedMemorySize, LDS_BYTES) != hipSuccess) { fprintf(stderr, "kernel_launch: hipFuncSetAttribute failed\n"); grid = -1; return; }
        if (hipOccupancyMaxActiveBlocksPerMultiprocessor(&per_cu, (const void*)mega_fwd, NTHREADS, LDS_BYTES) != hipSuccess || per_cu < 1) { fprintf(stderr, "kernel_launch: occupancy query says %d\n", per_cu); grid = -1; return; }
        grid = cus;
    }
    if (grid < 0) return;
    Args a{};
    for (int i = 0; i < 19; ++i) a.in[i] = (const float*)d_in[i];
    a.out = (float*)d_out; a.ws = (unsigned char*)d_ws;
    void* kargs[] = {&a};
    hipError_t e = hipLaunchCooperativeKernel((const void*)mega_fwd, dim3(grid), dim3(NTHREADS), kargs, LDS_BYTES, stream);
    if (e != hipSuccess) fprintf(stderr, "kernel_launch: cooperative launch failed: %s (grid %d)\n", hipGetErrorString(e), grid);
}
```

```cpp
#include <hip/hip_runtime.h>
#include <hip/hip_cooperative_groups.h>
#include <cstdio>
#include <cstdint>
namespace cg = cooperative_groups;
namespace pg8 {
#define PG8_LAS __attribute__((address_space(3)))
typedef unsigned short bf16_t;
typedef short bf16x8 __attribute__((ext_vector_type(8)));
typedef float f32x4 __attribute__((ext_vector_type(4)));
typedef unsigned u32x4 __attribute__((ext_vector_type(4)));
constexpr int BM = 256, BK = 64, HALF = 128, HTB = HALF * BK * 2  , STAGE_BYTES = 8 * HTB, NXCD = 8, WGM = 8;

__host__ __device__ __forceinline__ int lds_byte(int r, int c) { const int st = (r >> 4) * 2 + (c >> 5), rr = r & 15, cc = c & 31, ob = rr * 64 + cc * 2; return st * 1024 + (ob ^ (((ob >> 9) & 1) << 5)); }
__host__ __device__ __forceinline__ void stage_rc(int b, int& R, int& C) { const int st = b / 1024, sb = b % 1024, swz = sb ^ (((sb >> 9) & 1) << 5); R = (st >> 1) * 16 + swz / 64; C = (st & 1) * 32 + (swz % 64) / 2; }
__host__ __device__ __forceinline__ int perm32(int rho) { const int n = rho >> 4, i = rho & 15; return 8 * (i >> 2) + 4 * n + (i & 3); }

struct Unit { int pm, pn, k0; };
struct Gemm { const bf16_t* A; const bf16_t* Bt; int ld, K; };

struct StaticOrder {
    int nM, nN, nwg, G, c;
    __host__ __device__ void init(int M, int N, int G_, int c_) { nM = M / BM; nN = N / BM; nwg = nM * nN; G = G_; c = c_; }
    __host__ __device__ bool next(int i, Unit& u) const {
        const long L = (long)i * G + c; if (L >= nwg) return false;
        int wgid = (int)L; { const int q = nwg / NXCD, r = nwg % NXCD, xcd = wgid % NXCD, off = wgid / NXCD; wgid = (xcd < r ? xcd * (q + 1) : r * (q + 1) + (xcd - r) * q) + off; }
        const int nig = WGM * nN, gid = wgid / nig, fm = gid * WGM, gsz = (nM - fm) < WGM ? (nM - fm) : WGM;
        u.pm = fm + ((wgid % nig) % gsz); u.pn = (wgid % nig) / gsz; u.k0 = 0; return true;
    }
    __device__ __forceinline__ void a_ready(const Unit&) const {}
    __device__ __forceinline__ void done(const Unit&) const {}
};

__device__ __forceinline__ unsigned cvt_pk_bf16(float lo, float hi) { unsigned r; asm volatile("v_cvt_pk_bf16_f32 %0, %1, %2" : "=v"(r) : "v"(lo), "v"(hi)); return r; }
typedef float f32x2 __attribute__((ext_vector_type(2)));
__device__ __forceinline__ f32x2 gelu_pk(f32x2 v) {
    const f32x2 av = __builtin_elementwise_abs(v), d = av * 0.2316418882f + 1.0f;
    f32x2 t; t.x = __builtin_amdgcn_rcpf(d.x); t.y = __builtin_amdgcn_rcpf(d.y);
    f32x2 q = t * 0.5307027145f + (-0.7265760135f); q = q * t + 0.7107068705f; q = q * t + (-0.142248368f); q = q * t + 0.127414796f; q = q * t;
    const f32x2 s = (v * v) * (-0.72134752044f);
    f32x2 e; e.x = __builtin_amdgcn_exp2f(s.x); e.y = __builtin_amdgcn_exp2f(s.y);
    const f32x2 m = v * (q * e), r = v - m;
    f32x2 o; o.x = v.x < 0.f ? m.x : r.x; o.y = v.y < 0.f ? m.y : r.y; return o;
}

template <int ACT  > struct EpiBf16 {
    static constexpr bool PERM = true, AFTER_DRAIN = false; static_assert(ACT == 0 || ACT == 1, "EpiBf16: ACT is 0 (none) or 1 (gelu_pk)");
    bf16_t* O; int ldc; const float* bias; int split_cols; size_t split_stride; float scale0;
    __device__ __forceinline__ void operator()(const f32x4 (&acc)[2][2][4][2], const Unit& u, int wr, int wc, int fr, int fq) const {
        const int row0 = u.pm * BM + wr * 64 + fr; int colt = u.pn * BM; bf16_t* base = O;
        float sc = 1.f; if (split_cols) { const int t = colt / split_cols; base += (size_t)t * split_stride; colt -= t * split_cols; if (t == 0) sc = scale0; }
        const int col0 = colt + wc * 32 + 8 * fq, bcol0 = u.pn * BM + wc * 32 + 8 * fq;
        f32x4 bv[2][2];
#pragma unroll
        for (int bj = 0; bj < 2; ++bj)
#pragma unroll
            for (int n = 0; n < 2; ++n) bv[bj][n] = bias ? *(const f32x4*)(bias + bcol0 + bj * HALF + 4 * n) : (f32x4){0.f, 0.f, 0.f, 0.f};
#pragma unroll
        for (int ai = 0; ai < 2; ++ai)
#pragma unroll
            for (int m = 0; m < 4; ++m) { bf16_t* rowp = base + (size_t)(row0 + ai * HALF + m * 16) * ldc + col0;
#pragma unroll
                for (int bj = 0; bj < 2; ++bj) { f32x4 v0 = acc[ai][bj][m][0] + bv[bj][0], v1 = acc[ai][bj][m][1] + bv[bj][1];
                    if (ACT == 1) { f32x2 a = gelu_pk((f32x2){v0[0], v0[1]}), b = gelu_pk((f32x2){v0[2], v0[3]}), c = gelu_pk((f32x2){v1[0], v1[1]}), d = gelu_pk((f32x2){v1[2], v1[3]});
                        v0 = (f32x4){a.x, a.y, b.x, b.y}; v1 = (f32x4){c.x, c.y, d.x, d.y}; }
                    v0 = v0 * sc; v1 = v1 * sc; u32x4 w; w.x = cvt_pk_bf16(v0[0], v0[1]); w.y = cvt_pk_bf16(v0[2], v0[3]); w.z = cvt_pk_bf16(v1[0], v1[1]); w.w = cvt_pk_bf16(v1[2], v1[3]);
                    *(u32x4*)(rowp + bj * HALF) = w; } }
    }
};
constexpr int R_SAMPLE = 16384, R_META = 16896, R_END = 17024, MP = 17152, M2 = 16896, DM = 1024, NMT = MP / 256;
constexpr float RMS_EPS = 1e-6f;
typedef unsigned u32x2 __attribute__((ext_vector_type(2)));
__device__ __forceinline__ float bflo(unsigned w) { return __uint_as_float(w << 16); }
__device__ __forceinline__ float bfhi(unsigned w) { return __uint_as_float(w & 0xffff0000u); }
__device__ __forceinline__ float bf2f(bf16_t h) { return __uint_as_float((unsigned)h << 16); }
__device__ __forceinline__ float sigm(float x) { return __builtin_amdgcn_rcpf(1.f + __expf(-x)); }
struct RowMap { const float* xp; const float* xs; const float* meta; float* out; float* xscr; };
__device__ __forceinline__ const float* xrow_ptr(const RowMap& R, int r) {
    if (r < R_SAMPLE) return R.xp + (size_t)r * DM;
    if (r < R_META) return R.xs + (size_t)(r - R_SAMPLE) * DM;
    if (r < R_END) return R.meta + (size_t)((r - R_META) & 15) * DM;
    return nullptr;
}
__device__ __forceinline__ float* orow_ptr(const RowMap& R, int r) {
    if (r < M2) return R.out + (size_t)r * DM;
    return R.xscr + (size_t)(r - M2) * DM;
}

struct EpiMerge {
    static constexpr bool PERM = true, AFTER_DRAIN = false;
    const bf16_t* P; bf16_t* MG;
    __device__ __forceinline__ void operator()(const f32x4 (&acc)[2][2][4][2], const Unit& u, int wr, int wc, int fr, int fq) const {
        const int which = u.pm >= NMT ? 1 : 0; const int pm = u.pm - NMT * which, pn = u.pn - 4 * which;
        const int row0 = pm * BM + wr * 64 + fr, col0 = pn * BM + wc * 32 + 8 * fq;
        const bf16_t* gbase = P + 2048 + which * 1024;
#pragma unroll
        for (int ai = 0; ai < 2; ++ai)
#pragma unroll
            for (int m = 0; m < 4; ++m) { const size_t r = (size_t)(row0 + ai * HALF + m * 16);
#pragma unroll
                for (int bj = 0; bj < 2; ++bj) { const int c = col0 + bj * HALF;
                    const u32x4 gw = *(const u32x4*)(gbase + r * 4096 + c);
                    const f32x4 v0 = acc[ai][bj][m][0], v1 = acc[ai][bj][m][1];
                    float o0 = v0[0] * sigm(bflo(gw.x)), o1 = v0[1] * sigm(bfhi(gw.x)), o2 = v0[2] * sigm(bflo(gw.y)), o3 = v0[3] * sigm(bfhi(gw.y));
                    float o4 = v1[0] * sigm(bflo(gw.z)), o5 = v1[1] * sigm(bfhi(gw.z)), o6 = v1[2] * sigm(bflo(gw.w)), o7 = v1[3] * sigm(bfhi(gw.w));
                    bf16_t* dst = MG + r * 1024 + c;
                    if (which) { const u32x4 ow = *(const u32x4*)dst;
                        o0 += bflo(ow.x); o1 += bfhi(ow.x); o2 += bflo(ow.y); o3 += bfhi(ow.y); o4 += bflo(ow.z); o5 += bfhi(ow.z); o6 += bflo(ow.w); o7 += bfhi(ow.w); }
                    u32x4 w; w.x = cvt_pk_bf16(o0, o1); w.y = cvt_pk_bf16(o2, o3); w.z = cvt_pk_bf16(o4, o5); w.w = cvt_pk_bf16(o6, o7);
                    *(u32x4*)dst = w; } }
    }
};
struct EpiRes1 {
    static constexpr bool PERM = false, AFTER_DRAIN = false;
    RowMap R; bf16_t* X1B; float* SSP;
    __device__ __forceinline__ void operator()(const f32x4 (&acc)[2][2][4][2], const Unit& u, int wr, int wc, int fr, int fq) const {
        const int col0 = u.pn * BM + wc * 32 + 4 * fq;
#pragma unroll
        for (int ai = 0; ai < 2; ++ai)
#pragma unroll
            for (int m = 0; m < 4; ++m) { const int r = u.pm * BM + ai * HALF + wr * 64 + m * 16 + fr;
                const float* xr = xrow_ptr(R, r); float* orow = orow_ptr(R, r); float ss = 0.f;
#pragma unroll
                for (int bj = 0; bj < 2; ++bj)
#pragma unroll
                    for (int n = 0; n < 2; ++n) { const int c = col0 + bj * HALF + n * 16;
                        f32x4 v = acc[ai][bj][m][n]; if (xr) v += *(const f32x4*)(xr + c);
                        *(f32x4*)(orow + c) = v; ss += (v[0] * v[0] + v[1] * v[1]) + (v[2] * v[2] + v[3] * v[3]);
                        u32x2 w; w.x = cvt_pk_bf16(v[0], v[1]); w.y = cvt_pk_bf16(v[2], v[3]); *(u32x2*)(X1B + (size_t)r * DM + c) = w; }
                ss += __shfl_xor(ss, 16); ss += __shfl_xor(ss, 32);
                if (fq == 0) SSP[(size_t)r * 16 + u.pn * 4 + wc] = ss;
                if (m & 1) asm volatile("" ::: "memory"); }
    }
};
struct EpiSwiglu {
    static constexpr bool PERM = true, AFTER_DRAIN = false;
    const float* SSP; bf16_t* ACT; int ldact;
    __device__ __forceinline__ void operator()(const f32x4 (&acc)[2][2][4][2], const Unit& u, int wr, int wc, int fr, int fq) const {
        const int col0 = u.pn * HALF + wc * 32 + 8 * fq;
#pragma unroll
        for (int ai = 0; ai < 2; ++ai)
#pragma unroll
            for (int m = 0; m < 4; ++m) { const int r = u.pm * BM + ai * HALF + wr * 64 + m * 16 + fr;
                const f32x4* sp = (const f32x4*)(SSP + (size_t)r * 16); const f32x4 s0 = sp[0], s1 = sp[1], s2 = sp[2], s3 = sp[3];
                const float tot = (((s0[0] + s0[1]) + (s0[2] + s0[3])) + ((s1[0] + s1[1]) + (s1[2] + s1[3]))) + (((s2[0] + s2[1]) + (s2[2] + s2[3])) + ((s3[0] + s3[1]) + (s3[2] + s3[3])));
                const float rstd = rsqrtf(tot * (1.f / DM) + RMS_EPS);
                float o[8];
#pragma unroll
                for (int n = 0; n < 2; ++n)
#pragma unroll
                    for (int j = 0; j < 4; ++j) { const float g = acc[ai][0][m][n][j] * rstd, up = acc[ai][1][m][n][j] * rstd; o[n * 4 + j] = g * sigm(g) * up; }
                u32x4 w; w.x = cvt_pk_bf16(o[0], o[1]); w.y = cvt_pk_bf16(o[2], o[3]); w.z = cvt_pk_bf16(o[4], o[5]); w.w = cvt_pk_bf16(o[6], o[7]);
                *(u32x4*)(ACT + (size_t)r * ldact + col0) = w; }
    }
};
struct EpiRes2 {
    static constexpr bool PERM = false, AFTER_DRAIN = false;
    RowMap R;
    __device__ __forceinline__ void operator()(const f32x4 (&acc)[2][2][4][2], const Unit& u, int wr, int wc, int fr, int fq) const {
        const int col0 = u.pn * BM + wc * 32 + 4 * fq;
#pragma unroll
        for (int ai = 0; ai < 2; ++ai)
#pragma unroll
            for (int m = 0; m < 4; ++m) { const int r = u.pm * BM + ai * HALF + wr * 64 + m * 16 + fr;
                float* orow = orow_ptr(R, r);
#pragma unroll
                for (int bj = 0; bj < 2; ++bj)
#pragma unroll
                    for (int n = 0; n < 2; ++n) { const int c = col0 + bj * HALF + n * 16;
                        const f32x4 v = acc[ai][bj][m][n] + *(const f32x4*)(orow + c); *(f32x4*)(orow + c) = v; }
                if (m & 1) asm volatile("" ::: "memory"); }
    }
};
constexpr int NSPLIT = 11, KSPLIT = 256;
struct EpiPart {
    static constexpr bool PERM = false, AFTER_DRAIN = false;
    float* PART;
    __device__ __forceinline__ void operator()(const f32x4 (&acc)[2][2][4][2], const Unit& u, int wr, int wc, int fr, int fq) const {
        const int col0 = u.pn * BM + wc * 32 + 4 * fq; float* pb = PART + (size_t)(u.k0 / KSPLIT) * 512 * DM;
#pragma unroll
        for (int ai = 0; ai < 2; ++ai)
#pragma unroll
            for (int m = 0; m < 4; ++m) { const int r = u.pm * BM + ai * HALF + wr * 64 + m * 16 + fr - R_SAMPLE;
#pragma unroll
                for (int bj = 0; bj < 2; ++bj)
#pragma unroll
                    for (int n = 0; n < 2; ++n) *(f32x4*)(pb + (size_t)r * DM + col0 + bj * HALF + n * 16) = acc[ai][bj][m][n]; }
    }
};
struct PairOrder {
    StaticOrder base;
    __device__ void init(int G_, int c_) { base.init(M2, DM, G_, c_); }
    __device__ bool next(int i, Unit& u) const { if (!base.next(i >> 1, u)) return false; if (i & 1) { u.pm += NMT; u.pn += 4; } return true; }
    __device__ __forceinline__ void a_ready(const Unit&) const {}
    __device__ __forceinline__ void done(const Unit&) const {}
};
struct MiniOrder {
    int G, c;
    __device__ bool next(int i, Unit& u) const { const int L = i * G + c; if (L >= 8 * NSPLIT) return false; const int tile = L / NSPLIT, sp = L - tile * NSPLIT; u.pm = 64 + (tile >> 2); u.pn = tile & 3; u.k0 = sp * KSPLIT; return true; }
    __device__ __forceinline__ void a_ready(const Unit&) const {}
    __device__ __forceinline__ void done(const Unit&) const {}
};
template <class Epi, class Sched, bool ALIGN_EPI = false, bool SP2 = false>
__device__ __forceinline__ void gemm_phase(PG8_LAS unsigned char* lds, const Gemm g, const Sched& S, const Epi& E) {
    const int tid = threadIdx.x, wid = __builtin_amdgcn_readfirstlane(tid >> 6), lane = tid & 63, wr = wid >> 2, wc = wid & 3, fr = lane & 15, fq = lane >> 4;
    const int LD = g.ld, nt = g.K / BK;
    unsigned voffA[2], voffB[2];
#pragma unroll
    for (int i = 0; i < 2; ++i) { int R, C; stage_rc(tid * 16 + i * 8192, R, C); const int Rb = Epi::PERM ? ((R & ~31) + perm32(R & 31)) : R;
        voffA[i] = (unsigned)(R * LD + C) * 2u; voffB[i] = (unsigned)(Rb * LD + C) * 2u; }
    const size_t kstep = (size_t)(BK * 2);
    const size_t hstep = (size_t)HALF * LD * 2;
    const size_t tstep = 2 * hstep;
    const unsigned ldsw = (unsigned)wid * 1024u;
    const int aoff = lds_byte(wr * 64 + fr, fq * 8), boff = lds_byte(wc * 32 + fr, fq * 8);
#define PG8_SA(b, h) (((b) * 2 + (h)) * HTB)
#define PG8_SB(b, h) ((4 + (b) * 2 + (h)) * HTB)
#define PG8_STAGE(bufoff, gbase, voff) do { _Pragma("unroll") for (int _i = 0; _i < 2; ++_i) \
        __builtin_amdgcn_global_load_lds((const unsigned*)((const char*)(gbase) + (voff)[_i]), (PG8_LAS unsigned*)(lds + (bufoff) + ldsw + _i * 8192), 16, 0, 0); } while (0)
#define PG8_LDA(dst, b, h) do { _Pragma("unroll") for (int m = 0; m < 4; ++m) _Pragma("unroll") for (int k = 0; k < 2; ++k) dst[m][k] = *(const PG8_LAS bf16x8*)(lds + PG8_SA(b, h) + aoff + m * 2048 + k * 1024); } while (0)
#define PG8_LDB(dst, b, h) do { _Pragma("unroll") for (int n = 0; n < 2; ++n) _Pragma("unroll") for (int k = 0; k < 2; ++k) dst[n][k] = *(const PG8_LAS bf16x8*)(lds + PG8_SB(b, h) + boff + n * 2048 + k * 1024); } while (0)
#define PG8_MMA(ai, bj, At, Bt) do { __builtin_amdgcn_s_setprio(1); _Pragma("unroll") for (int m = 0; m < 4; ++m) _Pragma("unroll") for (int n = 0; n < 2; ++n) _Pragma("unroll") for (int k = 0; k < 2; ++k) \
        acc[ai][bj][m][n] = __builtin_amdgcn_mfma_f32_16x16x32_bf16(Bt[n][k], At[m][k], acc[ai][bj][m][n], 0, 0, 0); __builtin_amdgcn_s_setprio(0); } while (0)
#define PG8_WAIT_V(n) asm volatile("s_waitcnt vmcnt(" #n ")" ::: "memory")
#define PG8_WAIT_L(n) asm volatile("s_waitcnt lgkmcnt(" #n ")" ::: "memory")
#define PG8_BAR __builtin_amdgcn_s_barrier()
#define PG8_SCHED __builtin_amdgcn_sched_barrier(0)
    Unit cur, nxt; int ui = 0;
    if (!S.next(0, cur)) return;
    f32x4 acc[2][2][4][2];
#pragma unroll
    for (int a = 0; a < 2; ++a)
#pragma unroll
        for (int b = 0; b < 2; ++b)
#pragma unroll
            for (int m = 0; m < 4; ++m)
#pragma unroll
                for (int n = 0; n < 2; ++n) acc[a][b][m][n] = (f32x4){0.f, 0.f, 0.f, 0.f};
    bf16x8 At[4][2], B0[2][2], B1[2][2];
    const char* cA = (const char*)g.A + (size_t)cur.pm * tstep + (size_t)cur.k0 * 2; const char* cB = (const char*)g.Bt + (size_t)cur.pn * tstep + (size_t)cur.k0 * 2;
    S.a_ready(cur);
    if constexpr (SP2) {
        PG8_STAGE(PG8_SB(0, 0), cB, voffB); PG8_STAGE(PG8_SB(0, 1), cB + hstep, voffB); PG8_STAGE(PG8_SA(0, 0), cA, voffA); PG8_STAGE(PG8_SA(0, 1), cA + hstep, voffA);
        if (wr == 1) PG8_BAR;
        PG8_WAIT_V(2); PG8_BAR;
        PG8_STAGE(PG8_SB(1, 0), cB + kstep, voffB); PG8_STAGE(PG8_SA(1, 0), cA + kstep, voffA); PG8_STAGE(PG8_SB(1, 1), cB + hstep + kstep, voffB);
        PG8_WAIT_V(6); PG8_BAR;
    } else {
        PG8_STAGE(PG8_SB(0, 0), cB, voffB); PG8_STAGE(PG8_SA(0, 0), cA, voffA); PG8_STAGE(PG8_SB(0, 1), cB + hstep, voffB); PG8_STAGE(PG8_SA(0, 1), cA + hstep, voffA);
        if (wr == 1) PG8_BAR;
        PG8_WAIT_V(4); PG8_BAR;
        PG8_STAGE(PG8_SB(1, 0), cB + kstep, voffB); PG8_STAGE(PG8_SA(1, 0), cA + kstep, voffA); PG8_STAGE(PG8_SB(1, 1), cB + hstep + kstep, voffB);
        PG8_WAIT_V(6); PG8_BAR;
    }
    for (;;) {
        const bool has_next = S.next(ui + 1, nxt);
        const char* nA = has_next ? (const char*)g.A + (size_t)nxt.pm * tstep + (size_t)nxt.k0 * 2 : cA; const char* nB = has_next ? (const char*)g.Bt + (size_t)nxt.pn * tstep + (size_t)nxt.k0 * 2 : cB;
        for (int t = 0; t < nt; t += 2) {
            const bool last = (t == nt - 2);
            const char* a1 = cA + (size_t)(t + 1) * kstep;
            const char* a2 = last ? nA : cA + (size_t)(t + 2) * kstep; const char* b2 = last ? nB : cB + (size_t)(t + 2) * kstep;
            const char* a3 = a2 + kstep; const char* b3 = b2 + kstep;
            if (last && has_next) S.a_ready(nxt);
            if constexpr (SP2) {
            PG8_LDB(B0, 0, 0); PG8_LDB(B1, 0, 1); PG8_SCHED; PG8_LDA(At, 0, 0); PG8_STAGE(PG8_SA(1, 1), a1 + hstep, voffA);
            PG8_WAIT_V(8); PG8_WAIT_L(0); PG8_BAR; PG8_MMA(0, 0, At, B0); PG8_MMA(0, 1, At, B1); PG8_BAR; PG8_SCHED;
            PG8_LDA(At, 0, 1); PG8_STAGE(PG8_SB(0, 0), b2, voffB); PG8_STAGE(PG8_SB(0, 1), b2 + hstep, voffB); PG8_STAGE(PG8_SA(0, 0), a2, voffA);
            PG8_WAIT_V(8); PG8_WAIT_L(0); PG8_BAR; PG8_MMA(1, 0, At, B0); PG8_MMA(1, 1, At, B1); PG8_BAR; PG8_SCHED;
            PG8_LDB(B0, 1, 0); PG8_LDB(B1, 1, 1); PG8_SCHED; PG8_LDA(At, 1, 0); PG8_STAGE(PG8_SA(0, 1), a2 + hstep, voffA);
            PG8_WAIT_V(8); PG8_WAIT_L(0); PG8_BAR; PG8_MMA(0, 0, At, B0); PG8_MMA(0, 1, At, B1); PG8_BAR; PG8_SCHED;
            PG8_LDA(At, 1, 1); PG8_STAGE(PG8_SB(1, 0), b3, voffB); PG8_STAGE(PG8_SB(1, 1), b3 + hstep, voffB); PG8_STAGE(PG8_SA(1, 0), a3, voffA);
            PG8_WAIT_V(8); PG8_WAIT_L(0); PG8_BAR; PG8_MMA(1, 0, At, B0); PG8_MMA(1, 1, At, B1); PG8_BAR; PG8_SCHED;
            } else {
            PG8_LDB(B0, 0, 0); PG8_SCHED; PG8_LDA(At, 0, 0); PG8_STAGE(PG8_SA(1, 1), a1 + hstep, voffA);
            PG8_WAIT_L(8); PG8_BAR; PG8_WAIT_L(0); PG8_MMA(0, 0, At, B0); PG8_BAR; PG8_SCHED;
            PG8_LDB(B1, 0, 1); PG8_STAGE(PG8_SB(0, 0), b2, voffB);
            PG8_BAR; PG8_WAIT_L(0); PG8_MMA(0, 1, At, B1); PG8_BAR;
            PG8_LDA(At, 0, 1); PG8_STAGE(PG8_SA(0, 0), a2, voffA);
            PG8_BAR; PG8_WAIT_L(0); PG8_MMA(1, 0, At, B0); PG8_BAR; PG8_SCHED;
            PG8_STAGE(PG8_SB(0, 1), b2 + hstep, voffB);
            PG8_WAIT_V(6); PG8_BAR; PG8_MMA(1, 1, At, B1); PG8_BAR;
            PG8_LDB(B0, 1, 0); PG8_SCHED; PG8_LDA(At, 1, 0); PG8_STAGE(PG8_SA(0, 1), a2 + hstep, voffA);
            PG8_WAIT_L(8); PG8_BAR; PG8_WAIT_L(0); PG8_MMA(0, 0, At, B0); PG8_BAR; PG8_SCHED;
            PG8_LDB(B1, 1, 1); PG8_STAGE(PG8_SB(1, 0), b3, voffB);
            PG8_BAR; PG8_WAIT_L(0); PG8_MMA(0, 1, At, B1); PG8_BAR;
            PG8_LDA(At, 1, 1); PG8_STAGE(PG8_SA(1, 0), a3, voffA);
            PG8_BAR; PG8_WAIT_L(0); PG8_MMA(1, 0, At, B0); PG8_BAR; PG8_SCHED;
            PG8_STAGE(PG8_SB(1, 1), b3 + hstep, voffB);
            PG8_WAIT_V(6); PG8_BAR; PG8_MMA(1, 1, At, B1); PG8_BAR;
            }
        }
        if constexpr (ALIGN_EPI) { if (wr == 0) PG8_BAR; }
        if constexpr (!Epi::AFTER_DRAIN) { E(acc, cur, wr, wc, fr, fq); S.done(cur); }
        if (!has_next) break;
#pragma unroll
        for (int a = 0; a < 2; ++a)
#pragma unroll
            for (int b = 0; b < 2; ++b)
#pragma unroll
                for (int m = 0; m < 4; ++m)
#pragma unroll
                    for (int n = 0; n < 2; ++n) acc[a][b][m][n] = (f32x4){0.f, 0.f, 0.f, 0.f};
        cur = nxt; cA = nA; cB = nB; ++ui;
        if constexpr (ALIGN_EPI) { if (wr == 1) PG8_BAR; }
    }
    PG8_WAIT_V(0);
    if constexpr (!ALIGN_EPI) { if (wr == 0) PG8_BAR; }
    PG8_BAR;
    if constexpr (Epi::AFTER_DRAIN) { E.fused(acc, cur, wr, wc, fr, fq, lds, wid, lane); S.done(cur); }
#undef PG8_SA
#undef PG8_SB
#undef PG8_STAGE
#undef PG8_LDA
#undef PG8_LDB
#undef PG8_MMA
#undef PG8_WAIT_V
#undef PG8_WAIT_L
#undef PG8_BAR
#undef PG8_SCHED
}
}
#define LAS __attribute__((address_space(3)))
typedef unsigned short bf16;
typedef unsigned v4u __attribute__((ext_vector_type(4)));
typedef unsigned v2u __attribute__((ext_vector_type(2)));
typedef float f32x4 __attribute__((ext_vector_type(4)));
typedef short bf16x8 __attribute__((ext_vector_type(8)));
using pg8::R_META; using pg8::R_SAMPLE; using pg8::R_END; using pg8::MP; using pg8::M2; using pg8::DM; using pg8::NMT; using pg8::RMS_EPS;
using pg8::bf2f; using pg8::bflo; using pg8::bfhi; using pg8::sigm; using pg8::cvt_pk_bf16;
constexpr int NWAVES = 8, NTHREADS = 512;
constexpr int FF = 2816, NIN = 4096, INDIM = 4112, NBH = 32, NCH = 33, NITEM = NBH * NCH;
constexpr size_t MiB = 1u << 20;
constexpr size_t WS_CTL = 0, CTL_ZERO_BYTES = 16384;
constexpr size_t WS_WIN = 1 * MiB, WS_WCOMB = 9 * MiB, WS_WGP = 10 * MiB, WS_WOUT = 11 * MiB, WS_WFI = 13 * MiB, WS_WFO = 24 * MiB;
constexpr size_t WS_ZR = 30 * MiB;
constexpr size_t WS_XN = 32 * MiB;
constexpr size_t WS_P = 66 * MiB;
constexpr size_t WS_X1B = 160 * MiB;
constexpr size_t WS_QE = 200 * MiB, WS_KE = 209 * MiB;
constexpr size_t WS_POOLED = 218 * MiB, WS_OB = WS_POOLED + (size_t)MP * 512 * 2;
constexpr size_t WS_XS = 252 * MiB;
constexpr size_t WS_SSP1 = 253 * MiB, WS_SSP2 = 254 * MiB + MiB / 2;
constexpr size_t WS_END = 256 * MiB;
static_assert(WS_WCOMB + 1024 * 512 * 2 == WS_WGP && WS_OB + (size_t)MP * 512 * 2 <= WS_XS && WS_P + (size_t)MP * 2816 * 2 <= WS_X1B && WS_X1B + (size_t)MP * 1024 * 2 <= WS_QE, "ws map");
static_assert(WS_XN + (size_t)pg8::NSPLIT * 512 * 1024 * 4 <= WS_P, "PART");
static_assert(WS_P + (size_t)MP * 4096 * 2 <= WS_QE && WS_XN + (size_t)MP * 1024 * 2 <= WS_P && WS_SSP1 + (size_t)MP * 64 <= WS_SSP2 && WS_SSP2 + (size_t)MP * 64 <= WS_END && WS_WFO + 1024 * 2816 * 2 <= WS_ZR, "ws map 2");
constexpr size_t O_YP = 0, O_YS = 16777216, O_PBP = 17301504, O_GSP = 17362944, O_PBS = 17625088, O_GSS = 18608128, O_TOTAL = 22802432;
constexpr size_t OS_UT = 0;
constexpr size_t OS_SINT = 40 * MiB / 4;
constexpr size_t OS_DD = 60 * MiB / 4;
static_assert((size_t)NITEM * 8192 <= OS_SINT && OS_SINT + (size_t)NITEM * 8192 / 2 <= OS_DD && OS_DD + NITEM * 64 <= O_YS, "d_out scratch");
constexpr int WAVE_LDS = 18432, MISC_OFF = NWAVES * WAVE_LDS, LDS_BYTES = MISC_OFF + 256;
static_assert(LDS_BYTES >= pg8::STAGE_BYTES && LDS_BYTES >= 1024 * 80, "lds");

__device__ __forceinline__ unsigned f2bf(float f) { unsigned u = __builtin_bit_cast(unsigned, f); return (u + 0x7fffu + ((u >> 16) & 1u)) >> 16; }
__device__ __forceinline__ float wave_sum(float v) {
#pragma unroll
    for (int o = 1; o < 64; o <<= 1) v += __shfl_xor(v, o);
    return v;
}
__device__ __forceinline__ float logsig(float z) { return fminf(z, 0.f) - __logf(1.f + __expf(-fabsf(z))); }

#define XB_TMO      128
#define XB_XCNT(j)  (256  + 64 * (j))
#define XB_XSUB(j)  (1280 + 64 * (j))
#define XB_XGEN(j)  (2304 + 64 * (j))
#define XB_TOP      3328
#define XB_TOPGEN   3392
#define XCD_BAR_WORDS 3456
#define XB_SPIN_CAP (1u << 18)

__device__ __forceinline__ unsigned xb_ld(unsigned* p)              { return __hip_atomic_load(p, __ATOMIC_RELAXED, __HIP_MEMORY_SCOPE_AGENT); }
__device__ __forceinline__ unsigned xb_add(unsigned* p, unsigned v) { return __hip_atomic_fetch_add(p, v, __ATOMIC_RELAXED, __HIP_MEMORY_SCOPE_AGENT); }
__device__ __forceinline__ unsigned xb_xcc_id() { return (unsigned)__builtin_amdgcn_s_getreg((3 << 11) | 20) & 0xFu; }
#define XB_SPIN(cond, bar) do { unsigned _sp = 0; while (cond) { __builtin_amdgcn_s_sleep(1); \
    if ((++_sp & 255u) == 0u) { if (xb_ld(&(bar)[XB_TMO])) break; if (_sp > XB_SPIN_CAP) { atomicAdd(&(bar)[XB_TMO], 1u); break; } } } } while (0)

struct XcdBarrier {
    unsigned* bar; unsigned x;
    volatile LAS unsigned* st;
};

__device__ __forceinline__ XcdBarrier xcd_barrier_post(unsigned* bar, volatile LAS unsigned* st) {
    XcdBarrier b; b.bar = bar; b.x = xb_xcc_id(); b.st = st;
    if (threadIdx.x == 0) (void)xb_add(&bar[XB_XCNT(b.x)], 1u);
    return b;
}
__device__ __forceinline__ void xcd_barrier_complete(unsigned* bar, unsigned x, unsigned& nloc, unsigned& nx) {
    const unsigned G = gridDim.x * gridDim.y * gridDim.z;
    unsigned sum, cnt, mine, sp = 0u;
    for (;;) {
        sum = 0u; cnt = 0u; mine = 0u;
#pragma unroll
        for (unsigned j = 0; j < 16; ++j) { const unsigned c = xb_ld(&bar[XB_XCNT(j)]); sum += c; cnt += (c > 0u) ? 1u : 0u; mine = (j == x) ? c : mine; }
        if (sum == G) break;
        __builtin_amdgcn_s_sleep(1);
        if ((++sp & 255u) == 0u) { if (xb_ld(&bar[XB_TMO])) break; if (sp > XB_SPIN_CAP) { atomicAdd(&bar[XB_TMO], 1u); break; } }
    }
    nloc = mine > 0u ? mine : 1u; nx = cnt > 0u ? cnt : 1u;
}

__device__ __forceinline__ void xcd_barrier(const XcdBarrier& b) {
    asm volatile("s_waitcnt vmcnt(0)" ::: "memory");
    __syncthreads();
    if (threadIdx.x == 0) {
        unsigned* bar = b.bar;
        __builtin_amdgcn_s_waitcnt(0);
        unsigned nloc = b.st[0], nx = b.st[1];
        if (nloc == 0u) { xcd_barrier_complete(bar, b.x, nloc, nx); b.st[0] = nloc; b.st[1] = nx; }
        const unsigned old = xb_add(&bar[XB_XSUB(b.x)], 1u);
        const unsigned gen = old / nloc;
        if (old + 1u == (gen + 1u) * nloc) {
            __builtin_amdgcn_fence(__ATOMIC_RELEASE, "agent");
            asm volatile("s_waitcnt vmcnt(0)" ::: "memory");
            const unsigned og = xb_add(&bar[XB_TOP], 1u);
            const unsigned tg = og / nx;
            if (og + 1u == (tg + 1u) * nx) xb_add(&bar[XB_TOPGEN], 1u);
            else XB_SPIN(xb_ld(&bar[XB_TOPGEN]) == tg, bar);
            __builtin_amdgcn_fence(__ATOMIC_ACQUIRE, "agent");
            xb_add(&bar[XB_XGEN(b.x)], 1u);
            asm volatile("s_waitcnt vmcnt(0)" ::: "memory");
        } else {
            XB_SPIN(xb_ld(&bar[XB_XGEN(b.x)]) == gen, bar);
            __builtin_amdgcn_fence(__ATOMIC_ACQUIRE, "agent");
            asm volatile("s_waitcnt vmcnt(0)" ::: "memory");
        }
    }
    __syncthreads();
}

struct Args { const float* in[19]; float* out; unsigned char* ws; };

__device__ __forceinline__ void tr_item(const float* W, int ldw, bf16* WT, int K, int k0, int nsrc0, int ndst0, const float* kscale, LAS float* scr, int lane) {
    float tv[32];
#pragma unroll
    for (int i = 0; i < 32; ++i) { const int kk = 2 * i + (lane >> 5); tv[i] = W[(size_t)(k0 + kk) * ldw + nsrc0 + (lane & 31)]; }
#pragma unroll
    for (int i = 0; i < 32; ++i) { const int kk = 2 * i + (lane >> 5); float v = tv[i]; if (kscale) v *= kscale[k0 + kk]; scr[kk * 33 + (lane & 31)] = v; }
    asm volatile("s_waitcnt lgkmcnt(0)" ::: "memory");
    const int c = lane & 7;
#pragma unroll
    for (int j = 0; j < 4; ++j) { const int n = (lane >> 3) + 8 * j; const LAS float* s = scr + (8 * c) * 33 + n;
        v4u o; o.x = cvt_pk_bf16(s[0 * 33], s[1 * 33]); o.y = cvt_pk_bf16(s[2 * 33], s[3 * 33]); o.z = cvt_pk_bf16(s[4 * 33], s[5 * 33]); o.w = cvt_pk_bf16(s[6 * 33], s[7 * 33]);
        *(v4u*)(WT + (size_t)(ndst0 + n) * K + k0 + 8 * c) = o; }
    asm volatile("s_waitcnt lgkmcnt(0)" ::: "memory");
}

struct GateCol { float w[16]; float bias; };
__device__ __forceinline__ float gate_logdecay(const GateCol& gc, const float* ZR, int row) {
    const f32x4* zp = (const f32x4*)(ZR + (size_t)row * 16); const f32x4 a = zp[0], b = zp[1], c = zp[2], d = zp[3];
    float z = gc.bias;
    z += a[0] * gc.w[0]; z += a[1] * gc.w[1]; z += a[2] * gc.w[2]; z += a[3] * gc.w[3];
    z += b[0] * gc.w[4]; z += b[1] * gc.w[5]; z += b[2] * gc.w[6]; z += b[3] * gc.w[7];
    z += c[0] * gc.w[8]; z += c[1] * gc.w[9]; z += c[2] * gc.w[10]; z += c[3] * gc.w[11];
    z += d[0] * gc.w[12]; z += d[1] * gc.w[13]; z += d[2] * gc.w[14]; z += d[3] * gc.w[15];
    return logsig(z) * (1.f / 16.f);
}

template <int CTRL, int ROWMASK> __device__ __forceinline__ float dpp_add(float v) {
    const int t = __builtin_amdgcn_update_dpp(0, __builtin_bit_cast(int, v), CTRL, ROWMASK, 0xf, false);
    return v + __builtin_bit_cast(float, t);
}
__device__ __forceinline__ float scan_incl(float v) {
    v = dpp_add<0x111, 0xf>(v); v = dpp_add<0x112, 0xf>(v); v = dpp_add<0x114, 0xf>(v); v = dpp_add<0x118, 0xf>(v);
    v = dpp_add<0x142, 0xa>(v); v = dpp_add<0x143, 0xc>(v);
    return v;
}
__device__ __forceinline__ float lane_bcast(float v, int l) { return __builtin_bit_cast(float, __builtin_amdgcn_readlane(__builtin_bit_cast(int, v), l)); }
__device__ __forceinline__ void gla_a_item(int it, LAS unsigned char* wl, int lane, const bf16* P, const float* ZR, const float* w_gk_up, const float* b_gk,
                                           bf16* QE, bf16* KE, float* UT, float* DDp) {
    const int vh = it & 1, item = it >> 1, c = item % NCH, bh = item / NCH, b = bh >> 2, h = bh & 3;
    const int base = c == 0 ? R_META + b * 16 : b * 2048 + (c - 1) * 64, ntok = c == 0 ? 16 : 64;
    LAS unsigned char* kdt = wl; LAS unsigned char* vs = wl + 9216;
    const bool valid = lane < ntok; const size_t row = (size_t)(base + (valid ? lane : 0));
#pragma unroll
    for (int i = 0; i < 8; ++i) { const int rr = (lane >> 3) + 8 * i, ch = lane & 7; v4u val = (v4u){0u, 0u, 0u, 0u};
        if (rr < ntok) val = *(const v4u*)(P + (size_t)(base + rr) * NIN + 1024 + h * 128 + vh * 64 + ch * 8);
        *(LAS v4u*)(vs + rr * 144 + ch * 16) = val; }
    f32x4 zr[4];
#pragma unroll
    for (int i = 0; i < 4; ++i) zr[i] = *(const f32x4*)(ZR + row * 16 + 4 * i);
    float wreg[16];
#pragma unroll
    for (int o = 0; o < 16; ++o) wreg[o] = w_gk_up[o * 256 + h * 64 + lane];
    const float breg = b_gk[h * 64 + lane];
    const bf16* srow = P + row * NIN + (vh == 0 ? 512 : 768) + h * 64;
    const bf16* krow = P + row * NIN + 768 + h * 64;
    bf16* dst = (vh == 0 ? QE : KE) + row * 256 + h * 64;
    v4u kn = *(const v4u*)krow, sn = *(const v4u*)srow;
#pragma unroll 1
    for (int i = 0; i < 8; ++i) {
        const v4u kc = kn, scv = sn;
        if (i < 7) { kn = *(const v4u*)(krow + 8 * (i + 1)); sn = *(const v4u*)(srow + 8 * (i + 1)); }
        unsigned outw[4];
#pragma unroll
        for (int e2 = 0; e2 < 4; ++e2) { float ov[2];
#pragma unroll
            for (int t = 0; t < 2; ++t) { const int kd = 8 * i + 2 * e2 + t;
                float z = lane_bcast(breg, kd);
#pragma unroll
                for (int o = 0; o < 16; ++o) z += zr[o >> 2][o & 3] * lane_bcast(wreg[o], kd);
                const float g = valid ? logsig(z) * (1.f / 16.f) : 0.f;
                const float bc = scan_incl(g);
                const float blast = lane_bcast(bc, 63);
                const float kv = valid ? (t ? bfhi(kc[e2]) : bflo(kc[e2])) : 0.f, sv = t ? bfhi(scv[e2]) : bflo(scv[e2]);
                ov[t] = vh == 0 ? sv * 0.125f * __expf(bc) : sv * __expf(-bc);
                *(LAS unsigned short*)(kdt + kd * 144 + lane * 2) = (unsigned short)f2bf(kv * __expf(blast - bc));
                if (vh == 0 && lane == 0) DDp[item * 64 + kd] = __expf(blast); }
            outw[e2] = cvt_pk_bf16(ov[0], ov[1]); }
        if (valid) *(v4u*)(dst + 8 * i) = (v4u){outw[0], outw[1], outw[2], outw[3]};
    }
    const int n = lane & 15, quad = lane >> 4;
    bf16x8 bv[2][4];
#pragma unroll
    for (int p = 0; p < 2; ++p)
#pragma unroll
        for (int vt = 0; vt < 4; ++vt) {
#pragma unroll
            for (int e = 0; e < 8; ++e) bv[p][vt][e] = (short)*(const LAS unsigned short*)(vs + (p * 32 + quad * 8 + e) * 144 + (vt * 16 + n) * 2); }
#pragma unroll
    for (int kt = 0; kt < 4; ++kt) {
        const bf16x8 a0 = *(const LAS bf16x8*)(kdt + (kt * 16 + n) * 144 + (quad * 8) * 2), a1 = *(const LAS bf16x8*)(kdt + (kt * 16 + n) * 144 + (32 + quad * 8) * 2);
#pragma unroll
        for (int vt = 0; vt < 4; ++vt) { f32x4 acc = (f32x4){0.f, 0.f, 0.f, 0.f};
            acc = __builtin_amdgcn_mfma_f32_16x16x32_bf16(a0, bv[0][vt], acc, 0, 0, 0); acc = __builtin_amdgcn_mfma_f32_16x16x32_bf16(a1, bv[1][vt], acc, 0, 0, 0);
            const int v = vh * 64 + vt * 16 + n;
            *(f32x4*)(UT + ((size_t)item * 128 + v) * 64 + kt * 16 + quad * 4) = acc; }
    }
    asm volatile("s_waitcnt lgkmcnt(0)" ::: "memory");
}

__device__ __forceinline__ void gla_sample_item(int it, LAS unsigned char* wl, int lane, const bf16* P, const float* ZR, const float* w_gk_up, const float* b_gk,
                                                const float* state_in, float* state_out, const float* g_gla_norm, bf16* OB) {
    const int sb = it >> 2, h = it & 3, base = R_SAMPLE + sb * 4;
    LAS float* qs = (LAS float*)wl; LAS float* ks = qs + 256; LAS float* ds = ks + 256;
    GateCol gc;
#pragma unroll
    for (int r = 0; r < 16; ++r) gc.w[r] = w_gk_up[r * 256 + h * 64 + lane];
    gc.bias = b_gk[h * 64 + lane];
    float bcum[4], qv[4], kv[4]; float bc = 0.f;
#pragma unroll
    for (int j = 0; j < 4; ++j) { bc += gate_logdecay(gc, ZR, base + j); bcum[j] = bc;
        qv[j] = bf2f(P[(size_t)(base + j) * NIN + 512 + h * 64 + lane]); kv[j] = bf2f(P[(size_t)(base + j) * NIN + 768 + h * 64 + lane]); }
    float qe[4], ke[4];
#pragma unroll
    for (int j = 0; j < 4; ++j) { qe[j] = qv[j] * 0.125f * __expf(bcum[j]); ke[j] = kv[j] * __expf(-bcum[j]);
        qs[j * 64 + lane] = qe[j]; ks[j * 64 + lane] = kv[j] * __expf(bcum[3] - bcum[j]); }
    ds[lane] = __expf(bcum[3]);
    float att[4][4];
#pragma unroll
    for (int i = 0; i < 4; ++i)
#pragma unroll
        for (int j = 0; j < 4; ++j) att[i][j] = (j <= i) ? wave_sum(qe[i] * ke[j]) : 0.f;
    asm volatile("s_waitcnt lgkmcnt(0)" ::: "memory");
    float vv[4][2];
#pragma unroll
    for (int j = 0; j < 4; ++j) { vv[j][0] = bf2f(P[(size_t)(base + j) * NIN + 1024 + h * 128 + lane]); vv[j][1] = bf2f(P[(size_t)(base + j) * NIN + 1024 + h * 128 + 64 + lane]); }
    float o[4][2];
#pragma unroll
    for (int i = 0; i < 4; ++i) { o[i][0] = 0.f; o[i][1] = 0.f; }
    const float* sin_ = state_in + (size_t)it * 8192; float* sout = state_out + (size_t)it * 8192;
#pragma unroll 16
    for (int kd = 0; kd < 64; ++kd) {
        const float s0 = sin_[kd * 128 + lane], s1 = sin_[kd * 128 + 64 + lane];
        const float dk = ds[kd];
        float n0 = dk * s0, n1 = dk * s1;
#pragma unroll
        for (int i = 0; i < 4; ++i) { const float q = qs[i * 64 + kd], k = ks[i * 64 + kd]; o[i][0] += q * s0; o[i][1] += q * s1; n0 += k * vv[i][0]; n1 += k * vv[i][1]; }
        sout[kd * 128 + lane] = n0; sout[kd * 128 + 64 + lane] = n1;
    }
    const float gn0 = g_gla_norm[lane], gn1 = g_gla_norm[64 + lane];
#pragma unroll
    for (int i = 0; i < 4; ++i) {
#pragma unroll
        for (int j = 0; j < 4; ++j) if (j <= i) { o[i][0] += att[i][j] * vv[j][0]; o[i][1] += att[i][j] * vv[j][1]; }
        const float ss = wave_sum(o[i][0] * o[i][0] + o[i][1] * o[i][1]); const float rstd = rsqrtf(ss * (1.f / 128.f) + RMS_EPS);
        const float g0 = bf2f(P[(size_t)(base + i) * NIN + 1536 + h * 128 + lane]), g1 = bf2f(P[(size_t)(base + i) * NIN + 1536 + h * 128 + 64 + lane]);
        OB[(size_t)(base + i) * 512 + h * 128 + lane] = (bf16)f2bf(o[i][0] * rstd * gn0 * g0 * sigm(g0));
        OB[(size_t)(base + i) * 512 + h * 128 + 64 + lane] = (bf16)f2bf(o[i][1] * rstd * gn1 * g1 * sigm(g1));
    }
    asm volatile("s_waitcnt lgkmcnt(0)" ::: "memory");
}

__device__ __forceinline__ void ld8(const bf16* p, float (&v)[8]) { const v4u w = *(const v4u*)p; v[0] = bflo(w.x); v[1] = bfhi(w.x); v[2] = bflo(w.y); v[3] = bfhi(w.y); v[4] = bflo(w.z); v[5] = bfhi(w.z); v[6] = bflo(w.w); v[7] = bfhi(w.w); }
__device__ __forceinline__ void ld8f(const float* p, float (&v)[8]) { const f32x4 a = *(const f32x4*)p, b = *(const f32x4*)(p + 4); v[0] = a[0]; v[1] = a[1]; v[2] = a[2]; v[3] = a[3]; v[4] = b[0]; v[5] = b[1]; v[6] = b[2]; v[7] = b[3]; }
__device__ __forceinline__ void st8f(float* p, const float (&v)[8]) { *(f32x4*)p = (f32x4){v[0], v[1], v[2], v[3]}; *(f32x4*)(p + 4) = (f32x4){v[4], v[5], v[6], v[7]}; }
__device__ __forceinline__ void pool_item(int r, int lane, const bf16* P, const float* state_pool, bf16* POOLED, bf16* OB, float* out) {
    const int c0 = lane * 8, w = 2 << (lane >> 4);
    if (r >= R_END) { *(v4u*)(POOLED + (size_t)r * 512 + c0) = (v4u){0u, 0u, 0u, 0u}; *(v4u*)(OB + (size_t)r * 512 + c0) = (v4u){0u, 0u, 0u, 0u}; return; }
    float u[8], s[8]; ld8(P + (size_t)r * NIN + c0, u);
#pragma unroll
    for (int e = 0; e < 8; ++e) s[e] = u[e];
    float cnt = (float)w;
    if (r < R_SAMPLE) { const int b = r >> 11, t = r & 2047;
#pragma unroll
        for (int d = 1; d < 16; ++d) { const int tp = t - d; const int row = tp >= 0 ? r - d : R_META + b * 16 + 16 + tp; float x[8];
            if (d < w) { ld8(P + (size_t)row * NIN + c0, x);
#pragma unroll
                for (int e = 0; e < 8; ++e) s[e] += x[e]; } }
        if (t >= 2033) st8f(out + O_PBP + ((size_t)(b * 15 + (t - 2033))) * 512 + c0, u);
    } else if (r < R_META) { const int sb = (r - R_SAMPLE) >> 2, st = (r - R_SAMPLE) & 3;
#pragma unroll
        for (int d = 1; d < 16; ++d) { const int tp = st - d; float x[8];
            if (d < w) { if (tp >= 0) ld8(P + (size_t)(r - d) * NIN + c0, x); else ld8f(state_pool + ((size_t)sb * 15 + 15 + tp) * 512 + c0, x);
#pragma unroll
                for (int e = 0; e < 8; ++e) s[e] += x[e]; } }
        st8f(out + O_PBS + ((size_t)sb * 15 + 11 + st) * 512 + c0, u);
        if (st == 0) for (int k = 0; k < 11; ++k) { float x[8]; ld8f(state_pool + ((size_t)sb * 15 + 4 + k) * 512 + c0, x); st8f(out + O_PBS + ((size_t)sb * 15 + k) * 512 + c0, x); }
    } else { const int i = (r - R_META) & 15;
#pragma unroll
        for (int d = 1; d < 16; ++d) { float x[8];
            if (d < w && i - d >= 0) { ld8(P + (size_t)(r - d) * NIN + c0, x);
#pragma unroll
                for (int e = 0; e < 8; ++e) s[e] += x[e]; } }
        cnt = (float)(w < i + 1 ? w : i + 1);
    }
    const float inv = 1.f / cnt;
    v4u o; o.x = cvt_pk_bf16(s[0] * inv - u[0], s[1] * inv - u[1]); o.y = cvt_pk_bf16(s[2] * inv - u[2], s[3] * inv - u[3]);
    o.z = cvt_pk_bf16(s[4] * inv - u[4], s[5] * inv - u[5]); o.w = cvt_pk_bf16(s[6] * inv - u[6], s[7] * inv - u[7]);
    *(v4u*)(POOLED + (size_t)r * 512 + c0) = o;
}

template <int IH>
__device__ __forceinline__ void gla_c_item(int item, LAS unsigned char* wl, int lane, const bf16* P, const bf16* QE, const bf16* KE, const bf16* SINT, const float* g_gla_norm, bf16* OB) {
    const int c = item % NCH, bh = item / NCH, b = bh >> 2, h = bh & 3;
    const int base = c == 0 ? R_META + b * 16 : b * 2048 + (c - 1) * 64, ntok = c == 0 ? 16 : 64;
    const int n = lane & 15, quad = lane >> 4;
#pragma unroll
    for (int i = 0; i < 16; ++i) { const int row = (lane >> 4) + 4 * i, ch = lane & 15; v4u val = (v4u){0u, 0u, 0u, 0u};
        if (row < ntok) val = *(const v4u*)(P + (size_t)(base + row) * NIN + 1024 + h * 128 + ch * 8);
        *(LAS v4u*)(wl + row * 272 + ch * 16) = val; }
    bf16x8 qf[2][2];
#pragma unroll
    for (int li = 0; li < 2; ++li)
#pragma unroll
        for (int p = 0; p < 2; ++p) qf[li][p] = *(const bf16x8*)(QE + (size_t)(base + (2 * IH + li) * 16 + n) * 256 + h * 64 + p * 32 + quad * 8);
    constexpr int NJT = 2 * IH + 2;
    bf16x8 kf[NJT][2];
#pragma unroll
    for (int jt = 0; jt < NJT; ++jt)
#pragma unroll
        for (int p = 0; p < 2; ++p) kf[jt][p] = *(const bf16x8*)(KE + (size_t)(base + jt * 16 + n) * 256 + h * 64 + p * 32 + quad * 8);
    v4u af[2][IH + 1];
#pragma unroll
    for (int li = 0; li < 2; ++li) { const int itile = 2 * IH + li;
        f32x4 t[2 * IH + 2];
#pragma unroll
        for (int jt = 0; jt < 2 * IH + 2; ++jt) { f32x4 s = (f32x4){0.f, 0.f, 0.f, 0.f};
            if (jt <= itile) { s = __builtin_amdgcn_mfma_f32_16x16x32_bf16(kf[jt][0], qf[li][0], s, 0, 0, 0); s = __builtin_amdgcn_mfma_f32_16x16x32_bf16(kf[jt][1], qf[li][1], s, 0, 0, 0);
                if (jt == itile) {
#pragma unroll
                    for (int jj = 0; jj < 4; ++jj) if (quad * 4 + jj > n) s[jj] = 0.f; } }
            t[jt] = s; }
#pragma unroll
        for (int p = 0; p <= IH; ++p) { v4u a; a.x = cvt_pk_bf16(t[2 * p][0], t[2 * p][1]); a.y = cvt_pk_bf16(t[2 * p][2], t[2 * p][3]); a.z = cvt_pk_bf16(t[2 * p + 1][0], t[2 * p + 1][1]); a.w = cvt_pk_bf16(t[2 * p + 1][2], t[2 * p + 1][3]); af[li][p] = a; }
    }
    f32x4 acc[2][8];
#pragma unroll
    for (int li = 0; li < 2; ++li)
#pragma unroll
        for (int vt = 0; vt < 8; ++vt) acc[li][vt] = (f32x4){0.f, 0.f, 0.f, 0.f};
#pragma unroll
    for (int p = 0; p <= IH; ++p)
#pragma unroll
        for (int vt = 0; vt < 8; ++vt) { bf16x8 bvf;
#pragma unroll
            for (int e = 0; e < 8; ++e) { const int j = 32 * p + (e >> 2) * 16 + quad * 4 + (e & 3); bvf[e] = (short)*(const LAS unsigned short*)(wl + j * 272 + (vt * 16 + n) * 2); }
#pragma unroll
            for (int li = 0; li < 2; ++li) acc[li][vt] = __builtin_amdgcn_mfma_f32_16x16x32_bf16(__builtin_bit_cast(bf16x8, af[li][p]), bvf, acc[li][vt], 0, 0, 0); }
#pragma unroll
    for (int p = 0; p < 2; ++p)
#pragma unroll
        for (int vt = 0; vt < 8; ++vt) { const bf16x8 sf = *(const bf16x8*)(SINT + ((size_t)item * 128 + vt * 16 + n) * 64 + p * 32 + quad * 8);
#pragma unroll
            for (int li = 0; li < 2; ++li) acc[li][vt] = __builtin_amdgcn_mfma_f32_16x16x32_bf16(qf[li][p], sf, acc[li][vt], 0, 0, 0); }
#pragma unroll
    for (int li = 0; li < 2; ++li) { float ss[4] = {0.f, 0.f, 0.f, 0.f};
#pragma unroll
        for (int vt = 0; vt < 8; ++vt)
#pragma unroll
            for (int jj = 0; jj < 4; ++jj) ss[jj] += acc[li][vt][jj] * acc[li][vt][jj];
#pragma unroll
        for (int jj = 0; jj < 4; ++jj) { float s = ss[jj]; s += __shfl_xor(s, 1); s += __shfl_xor(s, 2); s += __shfl_xor(s, 4); s += __shfl_xor(s, 8);
            const float rstd = rsqrtf(s * (1.f / 128.f) + RMS_EPS); const int il = (2 * IH + li) * 16 + quad * 4 + jj;
            if (il < ntok) { const size_t row = (size_t)(base + il);
#pragma unroll
                for (int vt = 0; vt < 8; ++vt) { const int v = vt * 16 + n; const float og = bf2f(P[row * NIN + 1536 + h * 128 + v]);
                    OB[row * 512 + h * 128 + v] = (bf16)f2bf(acc[li][vt][jj] * rstd * g_gla_norm[v] * og * sigm(og)); } } }
    }
    asm volatile("s_waitcnt lgkmcnt(0)" ::: "memory");
}

__global__ void __launch_bounds__(NTHREADS, 2) mega_fwd(Args args) {
    extern __shared__ __attribute__((aligned(16))) unsigned char lds_raw[];
    LAS unsigned char* lds = (LAS unsigned char*)lds_raw;
    const int tid = threadIdx.x, lane = tid & 63, wave = __builtin_amdgcn_readfirstlane(tid >> 6);
    const int G = gridDim.x, gw = blockIdx.x * NWAVES + wave, NGW = G * NWAVES;
    LAS unsigned char* wl = lds + wave * WAVE_LDS;
    unsigned char* ws = args.ws; float* out = args.out;
    const float *x_prompt = args.in[0], *x_sample = args.in[1], *state_pool = args.in[2], *state_gla = args.in[3], *meta_tokens = args.in[4], *g_mix = args.in[5], *w_in = args.in[6], *w_gk_up = args.in[7], *b_gk = args.in[8],
                *w_pool_group = args.in[9], *pool_scale = args.in[10], *w_pool_proj = args.in[11], *g_gla_norm = args.in[12], *w_gla_proj = args.in[13], *w_out = args.in[14], *g_ffn = args.in[15], *w_ffn_in = args.in[16],
                *w_ffn_out = args.in[17], *g_final = args.in[18];
    bf16 *WinT = (bf16*)(ws + WS_WIN), *WcombT = (bf16*)(ws + WS_WCOMB), *WgpT = (bf16*)(ws + WS_WGP), *WoutT = (bf16*)(ws + WS_WOUT), *WfiT = (bf16*)(ws + WS_WFI), *WfoT = (bf16*)(ws + WS_WFO);
    float* ZR = (float*)(ws + WS_ZR); bf16* XN = (bf16*)(ws + WS_XN); bf16* MG = XN; bf16* P = (bf16*)(ws + WS_P); bf16* ACT = P; bf16* X1B = (bf16*)(ws + WS_X1B);
    bf16 *QE = (bf16*)(ws + WS_QE), *KE = (bf16*)(ws + WS_KE), *POOLED = (bf16*)(ws + WS_POOLED), *OB = (bf16*)(ws + WS_OB);
    float *XS = (float*)(ws + WS_XS), *SSP1 = (float*)(ws + WS_SSP1); float* PART = (float*)(ws + WS_XN);
    float* UT = out + OS_UT; bf16* SINT = (bf16*)(out + OS_SINT); float* DDp = out + OS_DD;
    const pg8::RowMap RM{x_prompt, x_sample, meta_tokens, out, XS};
    if (tid < 64) *(volatile LAS unsigned*)(lds + MISC_OFF + tid * 4) = 0u;
    __syncthreads();
    const XcdBarrier bar = xcd_barrier_post((unsigned*)(ws + WS_CTL), (volatile LAS unsigned*)(lds + MISC_OFF));
#define GRID_SYNC() xcd_barrier(bar)
#ifndef PROBE_MASK
#define PROBE_MASK 0
#endif
#define NREP(k) (((PROBE_MASK >> (k)) & 1) ? 2 : 1)

    for (int rep = 0; rep < NREP(0); ++rep) {
        LAS float* scr = (LAS float*)wl;
        constexpr int I_IN = 16 * 128, I_GP = 8 * 32, I_OUT = 16 * 32, I_FI = 16 * 176, I_FO = 44 * 32, I_ALL = I_IN + I_GP + I_OUT + I_FI + I_FO;
        for (int it = gw; it < I_ALL; it += NGW) {
            int r = it;
            if (r < I_IN) { const int kb = r / 128, n0 = (r % 128) * 32; tr_item(w_in, INDIM, WinT, 1024, kb * 64, n0 + (n0 >= 2048 ? 16 : 0), n0, nullptr, scr, lane); continue; } r -= I_IN;
            if (r < I_GP) { const int kb = r / 32, n0 = (r % 32) * 32; tr_item(w_gla_proj, 1024, WgpT, 512, kb * 64, n0, n0, nullptr, scr, lane); continue; } r -= I_GP;
            if (r < I_OUT) { const int kb = r / 32, n0 = (r % 32) * 32; tr_item(w_out, 1024, WoutT, 1024, kb * 64, n0, n0, nullptr, scr, lane); continue; } r -= I_OUT;
            if (r < I_FI) { const int kb = r / 176, n0 = (r % 176) * 32; const int pn = n0 >> 8, wi = n0 & 255; const int src = wi < 128 ? 128 * pn + wi : FF + 128 * pn + (wi - 128);
                tr_item(w_ffn_in, 2 * FF, WfiT, 1024, kb * 64, src, n0, g_ffn, scr, lane); continue; } r -= I_FI;
            { const int kb = r / 32, n0 = (r % 32) * 32; tr_item(w_ffn_out, 1024, WfoT, FF, kb * 64, n0, n0, nullptr, scr, lane); }
        }
        for (int idx = blockIdx.x * NTHREADS + tid; idx < 128 * 1024; idx += G * NTHREADS) {
            const int gq = __builtin_amdgcn_readfirstlane(idx >> 10), n = idx & 1023, g = gq >> 5;
            const float* wg = w_pool_group + (size_t)gq * 4 * 128; const float* sc = pool_scale + g * 128; const float* wp = w_pool_proj + (size_t)(g * 128) * 1024 + n;
            float a0 = 0.f, a1 = 0.f, a2 = 0.f, a3 = 0.f;
#pragma unroll 16
            for (int d = 0; d < 128; ++d) { const float t = sc[d] * wp[(size_t)d * 1024]; a0 += wg[d] * t; a1 += wg[128 + d] * t; a2 += wg[256 + d] * t; a3 += wg[384 + d] * t; }
            *(v2u*)(WcombT + (size_t)n * 512 + gq * 4) = (v2u){cvt_pk_bf16(a0, a1), cvt_pk_bf16(a2, a3)};
        }
        __syncthreads();
        for (int idx = tid; idx < 1024 * 16; idx += NTHREADS) { const int k = idx >> 4, o = idx & 15; *(LAS float*)(lds + k * 80 + o * 4) = w_in[(size_t)k * INDIM + 2048 + o]; }
        __syncthreads();
        float gm[16];
#pragma unroll
        for (int i = 0; i < 16; ++i) gm[i] = g_mix[lane + 64 * i];
        float xn[16];
        { const float* xr0 = pg8::xrow_ptr(RM, gw);
#pragma unroll
          for (int i = 0; i < 16; ++i) xn[i] = xr0 ? xr0[lane + 64 * i] : 0.f; }
        for (int r = gw; r < MP; r += NGW) {
            float x[16]; float ss = 0.f;
#pragma unroll
            for (int i = 0; i < 16; ++i) { x[i] = xn[i]; ss += x[i] * x[i]; }
            { const int rn = r + NGW; const float* xr1 = rn < MP ? pg8::xrow_ptr(RM, rn) : nullptr;
#pragma unroll
              for (int i = 0; i < 16; ++i) xn[i] = xr1 ? xr1[lane + 64 * i] : 0.f; }
            const float rstd = rsqrtf(wave_sum(ss) * (1.f / DM) + RMS_EPS);
            f32x4 z0 = (f32x4){0.f, 0.f, 0.f, 0.f}, z1 = z0, z2 = z0, z3 = z0;
#pragma unroll
            for (int i = 0; i < 16; ++i) { const float hv = x[i] * rstd * gm[i]; XN[(size_t)r * DM + lane + 64 * i] = (bf16)f2bf(hv);
                const LAS f32x4* wz = (const LAS f32x4*)(lds + (lane + 64 * i) * 80);
                z0 += hv * wz[0]; z1 += hv * wz[1]; z2 += hv * wz[2]; z3 += hv * wz[3];
                if (i & 1) __builtin_amdgcn_sched_barrier(0); }
            float zv = 0.f;
#pragma unroll
            for (int o = 0; o < 4; ++o) { const float a = wave_sum(z0[o]), b = wave_sum(z1[o]), c = wave_sum(z2[o]), d = wave_sum(z3[o]);
                zv = lane == o ? a : zv; zv = lane == 4 + o ? b : zv; zv = lane == 8 + o ? c : zv; zv = lane == 12 + o ? d : zv; }
            if (lane < 16) ZR[(size_t)r * 16 + lane] = zv;
        }
    }
    GRID_SYNC();
    for (int rep = 0; rep < NREP(1); ++rep) {
        pg8::Gemm g{XN, WinT, 1024, 1024}; pg8::StaticOrder S; S.init(MP, NIN, G, (int)blockIdx.x);
        pg8::EpiBf16<0> E{P, NIN, nullptr, 0, 0, 1.f};
        pg8::gemm_phase<pg8::EpiBf16<0>, pg8::StaticOrder, true, true>(lds, g, S, E);
    }
    GRID_SYNC();
    for (int rep = 0; rep < NREP(2); ++rep) {
        constexpr int N_A = 2 * NITEM, N_S = 512, N_ALL = N_A + N_S + MP;
        for (int it = gw; it < N_ALL; it += NGW) {
            if (it < N_A) gla_a_item(it, wl, lane, P, ZR, w_gk_up, b_gk, QE, KE, UT, DDp);
            else if (it < N_A + N_S) gla_sample_item(it - N_A, wl, lane, P, ZR, w_gk_up, b_gk, state_gla, out + O_GSS, g_gla_norm, OB);
            else pool_item(it - N_A - N_S, lane, P, state_pool, POOLED, OB, out);
        }
    }
    GRID_SYNC();
    for (int rep = 0; rep < NREP(3); ++rep)
    for (int e = blockIdx.x * NTHREADS + tid; e < NBH * 8192; e += G * NTHREADS) {
        const int bh = e >> 13, rem = e & 8191, v = rem >> 6, kd = rem & 63;
        float S = 0.f;
#pragma unroll 11
        for (int c = 0; c < NCH; ++c) { const size_t item = (size_t)bh * NCH + c;
            SINT[(item * 128 + v) * 64 + kd] = (bf16)f2bf(S);
            S = DDp[item * 64 + kd] * S + UT[(item * 128 + v) * 64 + kd]; }
        out[O_GSP + ((size_t)bh * 64 + kd) * 128 + v] = S;
    }
    GRID_SYNC();
    for (int rep = 0; rep < NREP(4); ++rep) {
        constexpr int N_C = 2 * NITEM;
        for (int it = gw; it < N_C; it += NGW) { const int item = it >> 1;
            if ((it & 1) == 0) gla_c_item<0>(item, wl, lane, P, QE, KE, SINT, g_gla_norm, OB);
            else if (item % NCH != 0) gla_c_item<1>(item, wl, lane, P, QE, KE, SINT, g_gla_norm, OB); }
    }
    GRID_SYNC();
    for (int rep = 0; rep < NREP(5); ++rep) {
        pg8::Gemm g{POOLED, WcombT, 512, 512}; pg8::PairOrder S; S.init(G, (int)blockIdx.x);
        pg8::EpiMerge E{P, MG};
        pg8::gemm_phase<pg8::EpiMerge, pg8::PairOrder, true, true>(lds, g, S, E);
    }
    GRID_SYNC();
    for (int rep = 0; rep < NREP(6); ++rep) {
        pg8::Gemm g{MG, WoutT, 1024, 1024}; pg8::StaticOrder S; S.init(M2, DM, G, (int)blockIdx.x);
        pg8::EpiRes1 E{RM, X1B, SSP1};
        pg8::gemm_phase<pg8::EpiRes1, pg8::StaticOrder, true, true>(lds, g, S, E);
    }
    GRID_SYNC();
    for (int rep = 0; rep < NREP(7); ++rep) {
        pg8::Gemm g{X1B, WfiT, 1024, 1024}; pg8::StaticOrder S; S.init(M2, 2 * FF, G, (int)blockIdx.x);
        pg8::EpiSwiglu E{SSP1, ACT, FF};
        pg8::gemm_phase<pg8::EpiSwiglu, pg8::StaticOrder, true, true>(lds, g, S, E);
    }
    GRID_SYNC();
    {
        pg8::Gemm g{ACT, WfoT, FF, FF}; pg8::StaticOrder S; S.init(R_SAMPLE, DM, G, (int)blockIdx.x);
        pg8::EpiRes2 E{RM};
        pg8::gemm_phase<pg8::EpiRes2, pg8::StaticOrder, true, true>(lds, g, S, E);
        pg8::Gemm g2{ACT, WfoT, FF, pg8::KSPLIT}; pg8::MiniOrder S2{G, (int)blockIdx.x};
        pg8::EpiPart E2{PART};
        pg8::gemm_phase<pg8::EpiPart, pg8::MiniOrder, true, true>(lds, g2, S2, E2);
    }
    GRID_SYNC();
    {
        f32x4 gf[4];
#pragma unroll
        for (int j = 0; j < 4; ++j) gf[j] = *(const f32x4*)(g_final + 4 * lane + 256 * j);
        for (int r0 = gw; r0 < M2; r0 += 2 * NGW) {
            f32x4 v[2][4];
#pragma unroll
            for (int q = 0; q < 2; ++q) { const int r = r0 + q * NGW;
                if (r < M2) {
#pragma unroll
                    for (int j = 0; j < 4; ++j) { v[q][j] = *(const f32x4*)(out + (size_t)r * DM + 4 * lane + 256 * j);
                        if (r >= R_SAMPLE) for (int sp = 0; sp < pg8::NSPLIT; ++sp) v[q][j] += *(const f32x4*)(PART + ((size_t)sp * 512 + (r - R_SAMPLE)) * DM + 4 * lane + 256 * j); } } }
#pragma unroll
            for (int q = 0; q < 2; ++q) { const int r = r0 + q * NGW;
                if (r < M2) { float ss = 0.f;
#pragma unroll
                    for (int j = 0; j < 4; ++j) ss += (v[q][j][0] * v[q][j][0] + v[q][j][1] * v[q][j][1]) + (v[q][j][2] * v[q][j][2] + v[q][j][3] * v[q][j][3]);
                    const float rstd = rsqrtf(wave_sum(ss) * (1.f / DM) + RMS_EPS);
#pragma unroll
                    for (int j = 0; j < 4; ++j) *(f32x4*)(out + (size_t)r * DM + 4 * lane + 256 * j) = v[q][j] * rstd * gf[j]; } }
        }
    }
}

extern "C" void kernel_launch(void* const* d_in, const int* in_sizes, int n_in, void* d_out, int out_size, void* d_ws, size_t ws_size, hipStream_t stream) {
    static int grid = 0;
    if (grid == 0) {
        if (n_in != 19 || (size_t)out_size != O_TOTAL || ws_size < WS_END) { fprintf(stderr, "kernel_launch: unexpected shapes (n_in %d out %d ws %zu)\n", n_in, out_size, ws_size); grid = -1; return; }
        int dev = 0, cus = 0, per_cu = 0;
        if (hipGetDevice(&dev) != hipSuccess || hipDeviceGetAttribute(&cus, hipDeviceAttributeMultiprocessorCount, dev) != hipSuccess) { grid = -1; return; }
        if (hipFuncSetAttribute((const void*)mega_fwd, hipFuncAttributeMaxDynamicSharedMemorySize, LDS_BYTES) != hipSuccess) { fprintf(stderr, "kernel_launch: hipFuncSetAttribute failed\n"); grid = -1; return; }
        if (hipOccupancyMaxActiveBlocksPerMultiprocessor(&per_cu, (const void*)mega_fwd, NTHREADS, LDS_BYTES) != hipSuccess || per_cu < 1) { fprintf(stderr, "kernel_launch: occupancy query says %d\n", per_cu); grid = -1; return; }
        grid = cus;
    }
    if (grid < 0) return;
    if (hipMemsetAsync((char*)d_ws + WS_CTL, 0, CTL_ZERO_BYTES, stream) != hipSuccess) { fprintf(stderr, "kernel_launch: memset failed\n"); return; }
    Args a{};
    for (int i = 0; i < 19; ++i) a.in[i] = (const float*)d_in[i];
    a.out = (float*)d_out; a.ws = (unsigned char*)d_ws;
    hipLaunchKernelGGL(mega_fwd, dim3(grid), dim3(NTHREADS), LDS_BYTES, stream, a);
    const hipError_t e = hipPeekAtLastError();
    if (e != hipSuccess) fprintf(stderr, "kernel_launch: launch failed: %s (grid %d)\n", hipGetErrorString(e), grid);
}
```

```cpp
#include <hip/hip_runtime.h>
#include <hip/hip_cooperative_groups.h>
#include <cstdio>
#include <cstdint>
namespace cg = cooperative_groups;
namespace pg8 {
#define PG8_LAS __attribute__((address_space(3)))
typedef unsigned short bf16_t;
typedef short bf16x8 __attribute__((ext_vector_type(8)));
typedef float f32x4 __attribute__((ext_vector_type(4)));
typedef unsigned u32x4 __attribute__((ext_vector_type(4)));
constexpr int BM = 256, BK = 64, HALF = 128, HTB = HALF * BK * 2  , STAGE_BYTES = 8 * HTB, NXCD = 8, WGM = 8;

__host__ __device__ __forceinline__ int lds_byte(int r, int c) { const int st = (r >> 4) * 2 + (c >> 5), rr = r & 15, cc = c & 31, ob = rr * 64 + cc * 2; return st * 1024 + (ob ^ (((ob >> 9) & 1) << 5)); }
__host__ __device__ __forceinline__ void stage_rc(int b, int& R, int& C) { const int st = b / 1024, sb = b % 1024, swz = sb ^ (((sb >> 9) & 1) << 5); R = (st >> 1) * 16 + swz / 64; C = (st & 1) * 32 + (swz % 64) / 2; }
__host__ __device__ __forceinline__ int perm32(int rho) { const int n = rho >> 4, i = rho & 15; return 8 * (i >> 2) + 4 * n + (i & 3); }

struct Unit { int pm, pn, k0; };
struct Gemm { const bf16_t* A; const bf16_t* Bt; int ld, K; };

struct StaticOrder {
    int nM, nN, nwg, G, c;
    __host__ __device__ void init(int M, int N, int G_, int c_) { nM = M / BM; nN = N / BM; nwg = nM * nN; G = G_; c = c_; }
    __host__ __device__ bool next(int i, Unit& u) const {
        const long L = (long)i * G + c; if (L >= nwg) return false;
        int wgid = (int)L; { const int q = nwg / NXCD, r = nwg % NXCD, xcd = wgid % NXCD, off = wgid / NXCD; wgid = (xcd < r ? xcd * (q + 1) : r * (q + 1) + (xcd - r) * q) + off; }
        const int nig = WGM * nN, gid = wgid / nig, fm = gid * WGM, gsz = (nM - fm) < WGM ? (nM - fm) : WGM;
        u.pm = fm + ((wgid % nig) % gsz); u.pn = (wgid % nig) / gsz; u.k0 = 0; return true;
    }
    __device__ __forceinline__ void a_ready(const Unit&) const {}
    __device__ __forceinline__ void done(const Unit&) const {}
};

__device__ __forceinline__ unsigned cvt_pk_bf16(float lo, float hi) { unsigned r; asm volatile("v_cvt_pk_bf16_f32 %0, %1, %2" : "=v"(r) : "v"(lo), "v"(hi)); return r; }
typedef float f32x2 __attribute__((ext_vector_type(2)));
__device__ __forceinline__ f32x2 gelu_pk(f32x2 v) {
    const f32x2 av = __builtin_elementwise_abs(v), d = av * 0.2316418882f + 1.0f;
    f32x2 t; t.x = __builtin_amdgcn_rcpf(d.x); t.y = __builtin_amdgcn_rcpf(d.y);
    f32x2 q = t * 0.5307027145f + (-0.7265760135f); q = q * t + 0.7107068705f; q = q * t + (-0.142248368f); q = q * t + 0.127414796f; q = q * t;
    const f32x2 s = (v * v) * (-0.72134752044f);
    f32x2 e; e.x = __builtin_amdgcn_exp2f(s.x); e.y = __builtin_amdgcn_exp2f(s.y);
    const f32x2 m = v * (q * e), r = v - m;
    f32x2 o; o.x = v.x < 0.f ? m.x : r.x; o.y = v.y < 0.f ? m.y : r.y; return o;
}

template <int ACT  > struct EpiBf16 {
    static constexpr bool PERM = true, AFTER_DRAIN = false; static_assert(ACT == 0 || ACT == 1, "EpiBf16: ACT is 0 (none) or 1 (gelu_pk)");
    bf16_t* O; int ldc; const float* bias; int split_cols; size_t split_stride; float scale0;
    __device__ __forceinline__ void operator()(const f32x4 (&acc)[2][2][4][2], const Unit& u, int wr, int wc, int fr, int fq) const {
        const int row0 = u.pm * BM + wr * 64 + fr; int colt = u.pn * BM; bf16_t* base = O;
        float sc = 1.f; if (split_cols) { const int t = colt / split_cols; base += (size_t)t * split_stride; colt -= t * split_cols; if (t == 0) sc = scale0; }
        const int col0 = colt + wc * 32 + 8 * fq, bcol0 = u.pn * BM + wc * 32 + 8 * fq;
        f32x4 bv[2][2];
#pragma unroll
        for (int bj = 0; bj < 2; ++bj)
#pragma unroll
            for (int n = 0; n < 2; ++n) bv[bj][n] = bias ? *(const f32x4*)(bias + bcol0 + bj * HALF + 4 * n) : (f32x4){0.f, 0.f, 0.f, 0.f};
#pragma unroll
        for (int ai = 0; ai < 2; ++ai)
#pragma unroll
            for (int m = 0; m < 4; ++m) { bf16_t* rowp = base + (size_t)(row0 + ai * HALF + m * 16) * ldc + col0;
#pragma unroll
                for (int bj = 0; bj < 2; ++bj) { f32x4 v0 = acc[ai][bj][m][0] + bv[bj][0], v1 = acc[ai][bj][m][1] + bv[bj][1];
                    if (ACT == 1) { f32x2 a = gelu_pk((f32x2){v0[0], v0[1]}), b = gelu_pk((f32x2){v0[2], v0[3]}), c = gelu_pk((f32x2){v1[0], v1[1]}), d = gelu_pk((f32x2){v1[2], v1[3]});
                        v0 = (f32x4){a.x, a.y, b.x, b.y}; v1 = (f32x4){c.x, c.y, d.x, d.y}; }
                    v0 = v0 * sc; v1 = v1 * sc; u32x4 w; w.x = cvt_pk_bf16(v0[0], v0[1]); w.y = cvt_pk_bf16(v0[2], v0[3]); w.z = cvt_pk_bf16(v1[0], v1[1]); w.w = cvt_pk_bf16(v1[2], v1[3]);
                    *(u32x4*)(rowp + bj * HALF) = w; } }
    }
};
constexpr int R_SAMPLE = 16384, R_META = 16896, R_END = 17024, MP = 17152, M2 = 16896, DM = 1024, NMT = MP / 256;
constexpr float RMS_EPS = 1e-6f;
typedef unsigned u32x2 __attribute__((ext_vector_type(2)));
__device__ __forceinline__ float bflo(unsigned w) { return __uint_as_float(w << 16); }
__device__ __forceinline__ float bfhi(unsigned w) { return __uint_as_float(w & 0xffff0000u); }
__device__ __forceinline__ float bf2f(bf16_t h) { return __uint_as_float((unsigned)h << 16); }
__device__ __forceinline__ float sigm(float x) { return __builtin_amdgcn_rcpf(1.f + __expf(-x)); }
struct RowMap { const float* xp; const float* xs; const float* meta; float* out; float* xscr; };
__device__ __forceinline__ const float* xrow_ptr(const RowMap& R, int r) {
    if (r < R_SAMPLE) return R.xp + (size_t)r * DM;
    if (r < R_META) return R.xs + (size_t)(r - R_SAMPLE) * DM;
    if (r < R_END) return R.meta + (size_t)((r - R_META) & 15) * DM;
    return nullptr;
}
__device__ __forceinline__ float* orow_ptr(const RowMap& R, int r) {
    if (r < M2) return R.out + (size_t)r * DM;
    return R.xscr + (size_t)(r - M2) * DM;
}

struct EpiIn {
    static constexpr bool PERM = true, AFTER_DRAIN = false;
    bf16_t* P; float* ZR;
    __device__ __forceinline__ void operator()(const f32x4 (&acc)[2][2][4][2], const Unit& u, int wr, int wc, int fr, int fq) const {
        const int row0 = u.pm * BM + wr * 64 + fr;
        if (u.pn < 16) { const int col0 = u.pn * BM + wc * 32 + 8 * fq;
#pragma unroll
            for (int ai = 0; ai < 2; ++ai)
#pragma unroll
                for (int m = 0; m < 4; ++m) { bf16_t* rowp = P + (size_t)(row0 + ai * HALF + m * 16) * 4096 + col0;
#pragma unroll
                    for (int bj = 0; bj < 2; ++bj) { const f32x4 v0 = acc[ai][bj][m][0], v1 = acc[ai][bj][m][1];
                        u32x4 w; w.x = cvt_pk_bf16(v0[0], v0[1]); w.y = cvt_pk_bf16(v0[2], v0[3]); w.z = cvt_pk_bf16(v1[0], v1[1]); w.w = cvt_pk_bf16(v1[2], v1[3]);
                        *(u32x4*)(rowp + bj * HALF) = w; } }
        } else if (wc == 0 && fq < 2) {
#pragma unroll
            for (int ai = 0; ai < 2; ++ai)
#pragma unroll
                for (int m = 0; m < 4; ++m) { float* zp = ZR + (size_t)(row0 + ai * HALF + m * 16) * 16 + 8 * fq;
                    *(f32x4*)zp = acc[ai][0][m][0]; *(f32x4*)(zp + 4) = acc[ai][0][m][1]; }
        }
    }
};
struct EpiMerge {
    static constexpr bool PERM = true, AFTER_DRAIN = false;
    const bf16_t* P; bf16_t* MG;
    __device__ __forceinline__ void operator()(const f32x4 (&acc)[2][2][4][2], const Unit& u, int wr, int wc, int fr, int fq) const {
        const int which = u.pm >= NMT ? 1 : 0; const int pm = u.pm - NMT * which, pn = u.pn - 4 * which;
        const int row0 = pm * BM + wr * 64 + fr, col0 = pn * BM + wc * 32 + 8 * fq;
        const bf16_t* gbase = P + 2048 + which * 1024;
#pragma unroll
        for (int ai = 0; ai < 2; ++ai)
#pragma unroll
            for (int m = 0; m < 4; ++m) { const size_t r = (size_t)(row0 + ai * HALF + m * 16);
#pragma unroll
                for (int bj = 0; bj < 2; ++bj) { const int c = col0 + bj * HALF;
                    const u32x4 gw = *(const u32x4*)(gbase + r * 4096 + c);
                    const f32x4 v0 = acc[ai][bj][m][0], v1 = acc[ai][bj][m][1];
                    float o0 = v0[0] * sigm(bflo(gw.x)), o1 = v0[1] * sigm(bfhi(gw.x)), o2 = v0[2] * sigm(bflo(gw.y)), o3 = v0[3] * sigm(bfhi(gw.y));
                    float o4 = v1[0] * sigm(bflo(gw.z)), o5 = v1[1] * sigm(bfhi(gw.z)), o6 = v1[2] * sigm(bflo(gw.w)), o7 = v1[3] * sigm(bfhi(gw.w));
                    bf16_t* dst = MG + r * 1024 + c;
                    if (which) { const u32x4 ow = *(const u32x4*)dst;
                        o0 += bflo(ow.x); o1 += bfhi(ow.x); o2 += bflo(ow.y); o3 += bfhi(ow.y); o4 += bflo(ow.z); o5 += bfhi(ow.z); o6 += bflo(ow.w); o7 += bfhi(ow.w); }
                    u32x4 w; w.x = cvt_pk_bf16(o0, o1); w.y = cvt_pk_bf16(o2, o3); w.z = cvt_pk_bf16(o4, o5); w.w = cvt_pk_bf16(o6, o7);
                    *(u32x4*)dst = w; } }
    }
};
struct EpiRes1 {
    static constexpr bool PERM = false, AFTER_DRAIN = false;
    RowMap R; bf16_t* X1B; float* SSP;
    __device__ __forceinline__ void operator()(const f32x4 (&acc)[2][2][4][2], const Unit& u, int wr, int wc, int fr, int fq) const {
        const int col0 = u.pn * BM + wc * 32 + 4 * fq;
#pragma unroll
        for (int ai = 0; ai < 2; ++ai) {
            f32x4 xv[4][2][2];
#pragma unroll
            for (int m = 0; m < 4; ++m) { const int r = u.pm * BM + ai * HALF + wr * 64 + m * 16 + fr; const float* xr = xrow_ptr(R, r);
#pragma unroll
                for (int bj = 0; bj < 2; ++bj)
#pragma unroll
                    for (int n = 0; n < 2; ++n) xv[m][bj][n] = xr ? *(const f32x4*)(xr + col0 + bj * HALF + n * 16) : (f32x4){0.f, 0.f, 0.f, 0.f}; }
            asm volatile("" ::: "memory");
#pragma unroll
            for (int m = 0; m < 4; ++m) { const int r = u.pm * BM + ai * HALF + wr * 64 + m * 16 + fr; float* orow = orow_ptr(R, r); float ss = 0.f;
#pragma unroll
                for (int bj = 0; bj < 2; ++bj)
#pragma unroll
                    for (int n = 0; n < 2; ++n) { const int c = col0 + bj * HALF + n * 16;
                        const f32x4 v = acc[ai][bj][m][n] + xv[m][bj][n];
                        *(f32x4*)(orow + c) = v; ss += (v[0] * v[0] + v[1] * v[1]) + (v[2] * v[2] + v[3] * v[3]);
                        u32x2 w; w.x = cvt_pk_bf16(v[0], v[1]); w.y = cvt_pk_bf16(v[2], v[3]); *(u32x2*)(X1B + (size_t)r * DM + c) = w; }
                ss += __shfl_xor(ss, 16); ss += __shfl_xor(ss, 32);
                if (fq == 0) SSP[(size_t)r * 16 + u.pn * 4 + wc] = ss; }
            asm volatile("" ::: "memory"); }
    }
};
struct EpiSwiglu {
    static constexpr bool PERM = true, AFTER_DRAIN = false;
    const float* SSP; bf16_t* ACT; int ldact;
    __device__ __forceinline__ void operator()(const f32x4 (&acc)[2][2][4][2], const Unit& u, int wr, int wc, int fr, int fq) const {
        const int col0 = u.pn * HALF + wc * 32 + 8 * fq;
#pragma unroll
        for (int ai = 0; ai < 2; ++ai)
#pragma unroll
            for (int m = 0; m < 4; ++m) { const int r = u.pm * BM + ai * HALF + wr * 64 + m * 16 + fr;
                const f32x4* sp = (const f32x4*)(SSP + (size_t)r * 16); const f32x4 s0 = sp[0], s1 = sp[1], s2 = sp[2], s3 = sp[3];
                const float tot = (((s0[0] + s0[1]) + (s0[2] + s0[3])) + ((s1[0] + s1[1]) + (s1[2] + s1[3]))) + (((s2[0] + s2[1]) + (s2[2] + s2[3])) + ((s3[0] + s3[1]) + (s3[2] + s3[3])));
                const float rstd = rsqrtf(tot * (1.f / DM) + RMS_EPS);
                float o[8];
#pragma unroll
                for (int n = 0; n < 2; ++n)
#pragma unroll
                    for (int j = 0; j < 4; ++j) { const float g = acc[ai][0][m][n][j] * rstd, up = acc[ai][1][m][n][j] * rstd; o[n * 4 + j] = g * sigm(g) * up; }
                u32x4 w; w.x = cvt_pk_bf16(o[0], o[1]); w.y = cvt_pk_bf16(o[2], o[3]); w.z = cvt_pk_bf16(o[4], o[5]); w.w = cvt_pk_bf16(o[6], o[7]);
                *(u32x4*)(ACT + (size_t)r * ldact + col0) = w; }
    }
};
struct EpiRes2 {
    static constexpr bool PERM = false, AFTER_DRAIN = false;
    RowMap R;
    __device__ __forceinline__ void operator()(const f32x4 (&acc)[2][2][4][2], const Unit& u, int wr, int wc, int fr, int fq) const {
        const int col0 = u.pn * BM + wc * 32 + 4 * fq;
#pragma unroll
        for (int ai = 0; ai < 2; ++ai) {
            f32x4 xv[4][2][2];
#pragma unroll
            for (int m = 0; m < 4; ++m) { const float* orow = orow_ptr(R, u.pm * BM + ai * HALF + wr * 64 + m * 16 + fr);
#pragma unroll
                for (int bj = 0; bj < 2; ++bj)
#pragma unroll
                    for (int n = 0; n < 2; ++n) xv[m][bj][n] = *(const f32x4*)(orow + col0 + bj * HALF + n * 16); }
            asm volatile("" ::: "memory");
#pragma unroll
            for (int m = 0; m < 4; ++m) { float* orow = orow_ptr(R, u.pm * BM + ai * HALF + wr * 64 + m * 16 + fr);
#pragma unroll
                for (int bj = 0; bj < 2; ++bj)
#pragma unroll
                    for (int n = 0; n < 2; ++n) *(f32x4*)(orow + col0 + bj * HALF + n * 16) = acc[ai][bj][m][n] + xv[m][bj][n]; }
            asm volatile("" ::: "memory"); }
    }
};
constexpr int NSPLIT = 11, KSPLIT = 256;
struct EpiPart {
    static constexpr bool PERM = false, AFTER_DRAIN = false;
    float* PART;
    __device__ __forceinline__ void operator()(const f32x4 (&acc)[2][2][4][2], const Unit& u, int wr, int wc, int fr, int fq) const {
        const int col0 = u.pn * BM + wc * 32 + 4 * fq; float* pb = PART + (size_t)(u.k0 / KSPLIT) * 512 * DM;
#pragma unroll
        for (int ai = 0; ai < 2; ++ai)
#pragma unroll
            for (int m = 0; m < 4; ++m) { const int r = u.pm * BM + ai * HALF + wr * 64 + m * 16 + fr - R_SAMPLE;
#pragma unroll
                for (int bj = 0; bj < 2; ++bj)
#pragma unroll
                    for (int n = 0; n < 2; ++n) *(f32x4*)(pb + (size_t)r * DM + col0 + bj * HALF + n * 16) = acc[ai][bj][m][n]; }
    }
};
struct PairOrder {
    StaticOrder base;
    __device__ void init(int G_, int c_) { base.init(M2, DM, G_, c_); }
    __device__ bool next(int i, Unit& u) const { if (!base.next(i >> 1, u)) return false; if (i & 1) { u.pm += NMT; u.pn += 4; } return true; }
    __device__ __forceinline__ void a_ready(const Unit&) const {}
    __device__ __forceinline__ void done(const Unit&) const {}
};
struct MiniOrder {
    int G, c;
    __device__ bool next(int i, Unit& u) const { const int L = i * G + c; if (L >= 8 * NSPLIT) return false; const int tile = L / NSPLIT, sp = L - tile * NSPLIT; u.pm = 64 + (tile >> 2); u.pn = tile & 3; u.k0 = sp * KSPLIT; return true; }
    __device__ __forceinline__ void a_ready(const Unit&) const {}
    __device__ __forceinline__ void done(const Unit&) const {}
};
template <class Epi, class Sched, bool ALIGN_EPI = false, bool SP2 = false>
__device__ __forceinline__ void gemm_phase(PG8_LAS unsigned char* lds, const Gemm g, const Sched& S, const Epi& E) {
    const int tid = threadIdx.x, wid = __builtin_amdgcn_readfirstlane(tid >> 6), lane = tid & 63, wr = wid >> 2, wc = wid & 3, fr = lane & 15, fq = lane >> 4;
    const int LD = g.ld, nt = g.K / BK;
    unsigned voffA[2], voffB[2];
#pragma unroll
    for (int i = 0; i < 2; ++i) { int R, C; stage_rc(tid * 16 + i * 8192, R, C); const int Rb = Epi::PERM ? ((R & ~31) + perm32(R & 31)) : R;
        voffA[i] = (unsigned)(R * LD + C) * 2u; voffB[i] = (unsigned)(Rb * LD + C) * 2u; }
    const size_t kstep = (size_t)(BK * 2);
    const size_t hstep = (size_t)HALF * LD * 2;
    const size_t tstep = 2 * hstep;
    const unsigned ldsw = (unsigned)wid * 1024u;
    const int aoff = lds_byte(wr * 64 + fr, fq * 8), boff = lds_byte(wc * 32 + fr, fq * 8);
#define PG8_SA(b, h) (((b) * 2 + (h)) * HTB)
#define PG8_SB(b, h) ((4 + (b) * 2 + (h)) * HTB)
#define PG8_STAGE(bufoff, gbase, voff) do { _Pragma("unroll") for (int _i = 0; _i < 2; ++_i) \
        __builtin_amdgcn_global_load_lds((const unsigned*)((const char*)(gbase) + (voff)[_i]), (PG8_LAS unsigned*)(lds + (bufoff) + ldsw + _i * 8192), 16, 0, 0); } while (0)
#define PG8_LDA(dst, b, h) do { _Pragma("unroll") for (int m = 0; m < 4; ++m) _Pragma("unroll") for (int k = 0; k < 2; ++k) dst[m][k] = *(const PG8_LAS bf16x8*)(lds + PG8_SA(b, h) + aoff + m * 2048 + k * 1024); } while (0)
#define PG8_LDB(dst, b, h) do { _Pragma("unroll") for (int n = 0; n < 2; ++n) _Pragma("unroll") for (int k = 0; k < 2; ++k) dst[n][k] = *(const PG8_LAS bf16x8*)(lds + PG8_SB(b, h) + boff + n * 2048 + k * 1024); } while (0)
#define PG8_MMA(ai, bj, At, Bt) do { __builtin_amdgcn_s_setprio(1); _Pragma("unroll") for (int m = 0; m < 4; ++m) _Pragma("unroll") for (int n = 0; n < 2; ++n) _Pragma("unroll") for (int k = 0; k < 2; ++k) \
        acc[ai][bj][m][n] = __builtin_amdgcn_mfma_f32_16x16x32_bf16(Bt[n][k], At[m][k], acc[ai][bj][m][n], 0, 0, 0); __builtin_amdgcn_s_setprio(0); } while (0)
#define PG8_WAIT_V(n) asm volatile("s_waitcnt vmcnt(" #n ")" ::: "memory")
#define PG8_WAIT_L(n) asm volatile("s_waitcnt lgkmcnt(" #n ")" ::: "memory")
#define PG8_BAR __builtin_amdgcn_s_barrier()
#define PG8_SCHED __builtin_amdgcn_sched_barrier(0)
    Unit cur, nxt; int ui = 0;
    if (!S.next(0, cur)) return;
    f32x4 acc[2][2][4][2];
#pragma unroll
    for (int a = 0; a < 2; ++a)
#pragma unroll
        for (int b = 0; b < 2; ++b)
#pragma unroll
            for (int m = 0; m < 4; ++m)
#pragma unroll
                for (int n = 0; n < 2; ++n) acc[a][b][m][n] = (f32x4){0.f, 0.f, 0.f, 0.f};
    bf16x8 At[4][2], B0[2][2], B1[2][2];
    const char* cA = (const char*)g.A + (size_t)cur.pm * tstep + (size_t)cur.k0 * 2; const char* cB = (const char*)g.Bt + (size_t)cur.pn * tstep + (size_t)cur.k0 * 2;
    S.a_ready(cur);
    if constexpr (SP2) {
        PG8_STAGE(PG8_SB(0, 0), cB, voffB); PG8_STAGE(PG8_SB(0, 1), cB + hstep, voffB); PG8_STAGE(PG8_SA(0, 0), cA, voffA); PG8_STAGE(PG8_SA(0, 1), cA + hstep, voffA);
        if (wr == 1) PG8_BAR;
        PG8_WAIT_V(2); PG8_BAR;
        PG8_STAGE(PG8_SB(1, 0), cB + kstep, voffB); PG8_STAGE(PG8_SA(1, 0), cA + kstep, voffA); PG8_STAGE(PG8_SB(1, 1), cB + hstep + kstep, voffB);
        PG8_WAIT_V(6); PG8_BAR;
    } else {
        PG8_STAGE(PG8_SB(0, 0), cB, voffB); PG8_STAGE(PG8_SA(0, 0), cA, voffA); PG8_STAGE(PG8_SB(0, 1), cB + hstep, voffB); PG8_STAGE(PG8_SA(0, 1), cA + hstep, voffA);
        if (wr == 1) PG8_BAR;
        PG8_WAIT_V(4); PG8_BAR;
        PG8_STAGE(PG8_SB(1, 0), cB + kstep, voffB); PG8_STAGE(PG8_SA(1, 0), cA + kstep, voffA); PG8_STAGE(PG8_SB(1, 1), cB + hstep + kstep, voffB);
        PG8_WAIT_V(6); PG8_BAR;
    }
    for (;;) {
        const bool has_next = S.next(ui + 1, nxt);
        const char* nA = has_next ? (const char*)g.A + (size_t)nxt.pm * tstep + (size_t)nxt.k0 * 2 : cA; const char* nB = has_next ? (const char*)g.Bt + (size_t)nxt.pn * tstep + (size_t)nxt.k0 * 2 : cB;
        for (int t = 0; t < nt; t += 2) {
            const bool last = (t == nt - 2);
            const char* a1 = cA + (size_t)(t + 1) * kstep;
            const char* a2 = last ? nA : cA + (size_t)(t + 2) * kstep; const char* b2 = last ? nB : cB + (size_t)(t + 2) * kstep;
            const char* a3 = a2 + kstep; const char* b3 = b2 + kstep;
            if (last && has_next) S.a_ready(nxt);
            if constexpr (SP2) {
            PG8_LDB(B0, 0, 0); PG8_LDB(B1, 0, 1); PG8_SCHED; PG8_LDA(At, 0, 0); PG8_STAGE(PG8_SA(1, 1), a1 + hstep, voffA);
            PG8_WAIT_V(8); PG8_WAIT_L(0); PG8_BAR; PG8_MMA(0, 0, At, B0); PG8_MMA(0, 1, At, B1); PG8_BAR; PG8_SCHED;
            PG8_LDA(At, 0, 1); PG8_STAGE(PG8_SB(0, 0), b2, voffB); PG8_STAGE(PG8_SB(0, 1), b2 + hstep, voffB); PG8_STAGE(PG8_SA(0, 0), a2, voffA);
            PG8_WAIT_V(8); PG8_WAIT_L(0); PG8_BAR; PG8_MMA(1, 0, At, B0); PG8_MMA(1, 1, At, B1); PG8_BAR; PG8_SCHED;
            PG8_LDB(B0, 1, 0); PG8_LDB(B1, 1, 1); PG8_SCHED; PG8_LDA(At, 1, 0); PG8_STAGE(PG8_SA(0, 1), a2 + hstep, voffA);
            PG8_WAIT_V(8); PG8_WAIT_L(0); PG8_BAR; PG8_MMA(0, 0, At, B0); PG8_MMA(0, 1, At, B1); PG8_BAR; PG8_SCHED;
            PG8_LDA(At, 1, 1); PG8_STAGE(PG8_SB(1, 0), b3, voffB); PG8_STAGE(PG8_SB(1, 1), b3 + hstep, voffB); PG8_STAGE(PG8_SA(1, 0), a3, voffA);
            PG8_WAIT_V(8); PG8_WAIT_L(0); PG8_BAR; PG8_MMA(1, 0, At, B0); PG8_MMA(1, 1, At, B1); PG8_BAR; PG8_SCHED;
            } else {
            PG8_LDB(B0, 0, 0); PG8_SCHED; PG8_LDA(At, 0, 0); PG8_STAGE(PG8_SA(1, 1), a1 + hstep, voffA);
            PG8_WAIT_L(8); PG8_BAR; PG8_WAIT_L(0); PG8_MMA(0, 0, At, B0); PG8_BAR; PG8_SCHED;
            PG8_LDB(B1, 0, 1); PG8_STAGE(PG8_SB(0, 0), b2, voffB);
            PG8_BAR; PG8_WAIT_L(0); PG8_MMA(0, 1, At, B1); PG8_BAR;
            PG8_LDA(At, 0, 1); PG8_STAGE(PG8_SA(0, 0), a2, voffA);
            PG8_BAR; PG8_WAIT_L(0); PG8_MMA(1, 0, At, B0); PG8_BAR; PG8_SCHED;
            PG8_STAGE(PG8_SB(0, 1), b2 + hstep, voffB);
            PG8_WAIT_V(6); PG8_BAR; PG8_MMA(1, 1, At, B1); PG8_BAR;
            PG8_LDB(B0, 1, 0); PG8_SCHED; PG8_LDA(At, 1, 0); PG8_STAGE(PG8_SA(0, 1), a2 + hstep, voffA);
            PG8_WAIT_L(8); PG8_BAR; PG8_WAIT_L(0); PG8_MMA(0, 0, At, B0); PG8_BAR; PG8_SCHED;
            PG8_LDB(B1, 1, 1); PG8_STAGE(PG8_SB(1, 0), b3, voffB);
            PG8_BAR; PG8_WAIT_L(0); PG8_MMA(0, 1, At, B1); PG8_BAR;
            PG8_LDA(At, 1, 1); PG8_STAGE(PG8_SA(1, 0), a3, voffA);
            PG8_BAR; PG8_WAIT_L(0); PG8_MMA(1, 0, At, B0); PG8_BAR; PG8_SCHED;
            PG8_STAGE(PG8_SB(1, 1), b3 + hstep, voffB);
            PG8_WAIT_V(6); PG8_BAR; PG8_MMA(1, 1, At, B1); PG8_BAR;
            }
        }
        if constexpr (ALIGN_EPI) { if (wr == 0) PG8_BAR; }
        if constexpr (!Epi::AFTER_DRAIN) { E(acc, cur, wr, wc, fr, fq); S.done(cur); }
        if (!has_next) break;
#pragma unroll
        for (int a = 0; a < 2; ++a)
#pragma unroll
            for (int b = 0; b < 2; ++b)
#pragma unroll
                for (int m = 0; m < 4; ++m)
#pragma unroll
                    for (int n = 0; n < 2; ++n) acc[a][b][m][n] = (f32x4){0.f, 0.f, 0.f, 0.f};
        cur = nxt; cA = nA; cB = nB; ++ui;
        if constexpr (ALIGN_EPI) { if (wr == 1) PG8_BAR; }
    }
    PG8_WAIT_V(0);
    if constexpr (!ALIGN_EPI) { if (wr == 0) PG8_BAR; }
    PG8_BAR;
    if constexpr (Epi::AFTER_DRAIN) { E.fused(acc, cur, wr, wc, fr, fq, lds, wid, lane); S.done(cur); }
#undef PG8_SA
#undef PG8_SB
#undef PG8_STAGE
#undef PG8_LDA
#undef PG8_LDB
#undef PG8_MMA
#undef PG8_WAIT_V
#undef PG8_WAIT_L
#undef PG8_BAR
#undef PG8_SCHED
}
}
#define LAS __attribute__((address_space(3)))
typedef unsigned short bf16;
typedef unsigned v4u __attribute__((ext_vector_type(4)));
typedef unsigned v2u __attribute__((ext_vector_type(2)));
typedef float f32x4 __attribute__((ext_vector_type(4)));
typedef short bf16x8 __attribute__((ext_vector_type(8)));
using pg8::R_META; using pg8::R_SAMPLE; using pg8::R_END; using pg8::MP; using pg8::M2; using pg8::DM; using pg8::NMT; using pg8::RMS_EPS;
using pg8::bf2f; using pg8::bflo; using pg8::bfhi; using pg8::sigm; using pg8::cvt_pk_bf16;
constexpr int NWAVES = 8, NTHREADS = 512;
constexpr int FF = 2816, NINP = 4352  , NIN = 4096, INDIM = 4112, NBH = 32, NCH = 33, NITEM = NBH * NCH;
constexpr size_t MiB = 1u << 20;
constexpr size_t WS_CTL = 0, CTL_ZERO_BYTES = 16384;
constexpr size_t WS_WIN = MiB / 2, WS_WCOMB = 9 * MiB, WS_WGP = 10 * MiB, WS_WOUT = 11 * MiB, WS_WFI = 13 * MiB, WS_WFO = 24 * MiB;
constexpr size_t WS_ZR = 30 * MiB;
constexpr size_t WS_XN = 32 * MiB;
constexpr size_t WS_P = 66 * MiB;
constexpr size_t WS_X1B = 160 * MiB;
constexpr size_t WS_QE = 200 * MiB, WS_KE = 209 * MiB;
constexpr size_t WS_POOLED = 218 * MiB, WS_OB = WS_POOLED + (size_t)MP * 512 * 2;
constexpr size_t WS_XS = 252 * MiB;
constexpr size_t WS_SSP1 = 253 * MiB, WS_SSP2 = 254 * MiB + MiB / 2;
constexpr size_t WS_END = 256 * MiB;
static_assert(WS_WCOMB + 1024 * 512 * 2 == WS_WGP && WS_OB + (size_t)MP * 512 * 2 <= WS_XS && WS_P + (size_t)MP * 2816 * 2 <= WS_X1B && WS_X1B + (size_t)MP * 1024 * 2 <= WS_QE, "ws map");
static_assert(WS_WIN + (size_t)NINP * 1024 * 2 <= WS_WCOMB, "WinT");
static_assert(WS_XN + (size_t)pg8::NSPLIT * 512 * 1024 * 4 <= WS_P, "PART");
static_assert(WS_P + (size_t)MP * 4096 * 2 <= WS_QE && WS_XN + (size_t)MP * 1024 * 2 <= WS_P && WS_SSP1 + (size_t)MP * 64 <= WS_SSP2 && WS_SSP2 + (size_t)MP * 64 <= WS_END && WS_WFO + 1024 * 2816 * 2 <= WS_ZR, "ws map 2");
constexpr size_t O_YP = 0, O_YS = 16777216, O_PBP = 17301504, O_GSP = 17362944, O_PBS = 17625088, O_GSS = 18608128, O_TOTAL = 22802432;
constexpr size_t OS_UT = 0;
constexpr size_t OS_SINT = 40 * MiB / 4;
constexpr size_t OS_DD = 60 * MiB / 4;
static_assert((size_t)NITEM * 8192 <= OS_SINT && OS_SINT + (size_t)NITEM * 8192 / 2 <= OS_DD && OS_DD + NITEM * 64 <= O_YS, "d_out scratch");
constexpr int WAVE_LDS = 18432, MISC_OFF = NWAVES * WAVE_LDS, LDS_BYTES = MISC_OFF + 256;
static_assert(LDS_BYTES >= pg8::STAGE_BYTES && LDS_BYTES >= 1024 * 80, "lds");

__device__ __forceinline__ unsigned f2bf(float f) { unsigned u = __builtin_bit_cast(unsigned, f); return (u + 0x7fffu + ((u >> 16) & 1u)) >> 16; }
template <int CTRL, int ROWMASK> __device__ __forceinline__ float dpp_add(float v) {
    const int t = __builtin_amdgcn_update_dpp(0, __builtin_bit_cast(int, v), CTRL, ROWMASK, 0xf, false);
    return v + __builtin_bit_cast(float, t);
}
__device__ __forceinline__ float scan_incl(float v) {
    v = dpp_add<0x111, 0xf>(v); v = dpp_add<0x112, 0xf>(v); v = dpp_add<0x114, 0xf>(v); v = dpp_add<0x118, 0xf>(v);
    v = dpp_add<0x142, 0xa>(v); v = dpp_add<0x143, 0xc>(v);
    return v;
}
__device__ __forceinline__ float lane_bcast(float v, int l) { return __builtin_bit_cast(float, __builtin_amdgcn_readlane(__builtin_bit_cast(int, v), l)); }
__device__ __forceinline__ float wave_sum(float v) { return lane_bcast(scan_incl(v), 63); }
__device__ __forceinline__ float logsig(float z) { return fminf(z, 0.f) - __logf(1.f + __expf(-fabsf(z))); }

#define XB_TMO      128
#define XB_XCNT(j)  (256  + 64 * (j))
#define XB_XSUB(j)  (1280 + 64 * (j))
#define XB_XGEN(j)  (2304 + 64 * (j))
#define XB_TOP      3328
#define XB_TOPGEN   3392
#define XCD_BAR_WORDS 3456
#define XB_SPIN_CAP (1u << 18)

__device__ __forceinline__ unsigned xb_ld(unsigned* p)              { return __hip_atomic_load(p, __ATOMIC_RELAXED, __HIP_MEMORY_SCOPE_AGENT); }
__device__ __forceinline__ unsigned xb_add(unsigned* p, unsigned v) { return __hip_atomic_fetch_add(p, v, __ATOMIC_RELAXED, __HIP_MEMORY_SCOPE_AGENT); }
__device__ __forceinline__ unsigned xb_xcc_id() { return (unsigned)__builtin_amdgcn_s_getreg((3 << 11) | 20) & 0xFu; }
#define XB_SPIN(cond, bar) do { unsigned _sp = 0; while (cond) { __builtin_amdgcn_s_sleep(1); \
    if ((++_sp & 255u) == 0u) { if (xb_ld(&(bar)[XB_TMO])) break; if (_sp > XB_SPIN_CAP) { atomicAdd(&(bar)[XB_TMO], 1u); break; } } } } while (0)

struct XcdBarrier {
    unsigned* bar; unsigned x;
    volatile LAS unsigned* st;
};

__device__ __forceinline__ XcdBarrier xcd_barrier_post(unsigned* bar, volatile LAS unsigned* st) {
    XcdBarrier b; b.bar = bar; b.x = xb_xcc_id(); b.st = st;
    if (threadIdx.x == 0) (void)xb_add(&bar[XB_XCNT(b.x)], 1u);
    return b;
}
__device__ __forceinline__ void xcd_barrier_complete(unsigned* bar, unsigned x, unsigned& nloc, unsigned& nx) {
    const unsigned G = gridDim.x * gridDim.y * gridDim.z;
    unsigned sum, cnt, mine, sp = 0u;
    for (;;) {
        sum = 0u; cnt = 0u; mine = 0u;
#pragma unroll
        for (unsigned j = 0; j < 16; ++j) { const unsigned c = xb_ld(&bar[XB_XCNT(j)]); sum += c; cnt += (c > 0u) ? 1u : 0u; mine = (j == x) ? c : mine; }
        if (sum == G) break;
        __builtin_amdgcn_s_sleep(1);
        if ((++sp & 255u) == 0u) { if (xb_ld(&bar[XB_TMO])) break; if (sp > XB_SPIN_CAP) { atomicAdd(&bar[XB_TMO], 1u); break; } }
    }
    nloc = mine > 0u ? mine : 1u; nx = cnt > 0u ? cnt : 1u;
}

__device__ __forceinline__ void xcd_barrier(const XcdBarrier& b) {
    asm volatile("s_waitcnt vmcnt(0)" ::: "memory");
    __syncthreads();
    if (threadIdx.x == 0) {
        unsigned* bar = b.bar;
        __builtin_amdgcn_s_waitcnt(0);
        unsigned nloc = b.st[0], nx = b.st[1];
        if (nloc == 0u) { xcd_barrier_complete(bar, b.x, nloc, nx); b.st[0] = nloc; b.st[1] = nx; }
        const unsigned old = xb_add(&bar[XB_XSUB(b.x)], 1u);
        const unsigned gen = old / nloc;
        if (old + 1u == (gen + 1u) * nloc) {
            __builtin_amdgcn_fence(__ATOMIC_RELEASE, "agent");
            asm volatile("s_waitcnt vmcnt(0)" ::: "memory");
            const unsigned og = xb_add(&bar[XB_TOP], 1u);
            const unsigned tg = og / nx;
            if (og + 1u == (tg + 1u) * nx) xb_add(&bar[XB_TOPGEN], 1u);
            else XB_SPIN(xb_ld(&bar[XB_TOPGEN]) == tg, bar);
            __builtin_amdgcn_fence(__ATOMIC_ACQUIRE, "agent");
            xb_add(&bar[XB_XGEN(b.x)], 1u);
            asm volatile("s_waitcnt vmcnt(0)" ::: "memory");
        } else {
            XB_SPIN(xb_ld(&bar[XB_XGEN(b.x)]) == gen, bar);
            __builtin_amdgcn_fence(__ATOMIC_ACQUIRE, "agent");
            asm volatile("s_waitcnt vmcnt(0)" ::: "memory");
        }
    }
    __syncthreads();
}

struct Args { const float* in[19]; float* out; unsigned char* ws; };

__device__ __forceinline__ void tr_item(const float* W, int ldw, bf16* WT, int K, int k0, int nsrc0, int ndst0, const float* kscale, LAS float* scr, int lane) {
    float tv[32];
#pragma unroll
    for (int i = 0; i < 32; ++i) { const int kk = 2 * i + (lane >> 5); tv[i] = W[(size_t)(k0 + kk) * ldw + nsrc0 + (lane & 31)]; }
#pragma unroll
    for (int i = 0; i < 32; ++i) { const int kk = 2 * i + (lane >> 5); float v = tv[i]; if (kscale) v *= kscale[k0 + kk]; scr[kk * 33 + (lane & 31)] = v; }
    asm volatile("s_waitcnt lgkmcnt(0)" ::: "memory");
    const int c = lane & 7;
#pragma unroll
    for (int j = 0; j < 4; ++j) { const int n = (lane >> 3) + 8 * j; const LAS float* s = scr + (8 * c) * 33 + n;
        v4u o; o.x = cvt_pk_bf16(s[0 * 33], s[1 * 33]); o.y = cvt_pk_bf16(s[2 * 33], s[3 * 33]); o.z = cvt_pk_bf16(s[4 * 33], s[5 * 33]); o.w = cvt_pk_bf16(s[6 * 33], s[7 * 33]);
        *(v4u*)(WT + (size_t)(ndst0 + n) * K + k0 + 8 * c) = o; }
    asm volatile("s_waitcnt lgkmcnt(0)" ::: "memory");
}

struct GateCol { float w[16]; float bias; };
__device__ __forceinline__ float gate_logdecay(const GateCol& gc, const float* ZR, int row) {
    const f32x4* zp = (const f32x4*)(ZR + (size_t)row * 16); const f32x4 a = zp[0], b = zp[1], c = zp[2], d = zp[3];
    float z = gc.bias;
    z += a[0] * gc.w[0]; z += a[1] * gc.w[1]; z += a[2] * gc.w[2]; z += a[3] * gc.w[3];
    z += b[0] * gc.w[4]; z += b[1] * gc.w[5]; z += b[2] * gc.w[6]; z += b[3] * gc.w[7];
    z += c[0] * gc.w[8]; z += c[1] * gc.w[9]; z += c[2] * gc.w[10]; z += c[3] * gc.w[11];
    z += d[0] * gc.w[12]; z += d[1] * gc.w[13]; z += d[2] * gc.w[14]; z += d[3] * gc.w[15];
    return logsig(z) * (1.f / 16.f);
}

__device__ __forceinline__ void gla_a_item(int it, LAS unsigned char* wl, int lane, const bf16* P, const float* ZR, const float* w_gk_up, const float* b_gk,
                                           bf16* QE, bf16* KE, float* UT, float* DDp) {
    const int kh = it & 1, item = it >> 1, c = item % NCH, bh = item / NCH, b = bh >> 2, h = bh & 3;
    const int base = c == 0 ? R_META + b * 16 : b * 2048 + (c - 1) * 64, ntok = c == 0 ? 16 : 64;
    LAS unsigned char* kdt = wl; LAS unsigned char* vs = wl + 4608;
    const bool valid = lane < ntok; const size_t row = (size_t)(base + (valid ? lane : 0));
#pragma unroll
    for (int i = 0; i < 8; ++i) { const int rr = (lane >> 3) + 8 * i, ch = lane & 7; v4u val = (v4u){0u, 0u, 0u, 0u};
        if (rr < ntok) val = *(const v4u*)(P + (size_t)(base + rr) * NIN + 1024 + h * 128 + ch * 8);
        *(LAS v4u*)(vs + rr * 144 + ch * 16) = val; }
    f32x4 zr[4];
#pragma unroll
    for (int i = 0; i < 4; ++i) zr[i] = *(const f32x4*)(ZR + row * 16 + 4 * i);
    float wreg[16];
#pragma unroll
    for (int o = 0; o < 16; ++o) wreg[o] = w_gk_up[o * 256 + h * 64 + lane];
    const float breg = b_gk[h * 64 + lane];
    const bf16* qrow = P + row * NIN + 512 + h * 64 + 32 * kh; const bf16* krow = P + row * NIN + 768 + h * 64 + 32 * kh;
    bf16* qdst = QE + row * 256 + h * 64 + 32 * kh; bf16* kdst = KE + row * 256 + h * 64 + 32 * kh;
    v4u kn = *(const v4u*)krow, qn = *(const v4u*)qrow;
#pragma unroll 1
    for (int i = 0; i < 4; ++i) {
        const v4u kc = kn, qc = qn;
        if (i < 3) { kn = *(const v4u*)(krow + 8 * (i + 1)); qn = *(const v4u*)(qrow + 8 * (i + 1)); }
        unsigned qo[4], ko[4];
#pragma unroll
        for (int e2 = 0; e2 < 4; ++e2) { float qev[2], kev[2];
#pragma unroll
            for (int t = 0; t < 2; ++t) { const int kdl = 8 * i + 2 * e2 + t, kd = 32 * kh + kdl;
                float z = lane_bcast(breg, kd);
#pragma unroll
                for (int o = 0; o < 16; ++o) z += zr[o >> 2][o & 3] * lane_bcast(wreg[o], kd);
                const float g = valid ? logsig(z) * (1.f / 16.f) : 0.f;
                const float bc = scan_incl(g);
                const float blast = lane_bcast(bc, 63);
                const float e1 = __expf(bc), e2r = __builtin_amdgcn_rcpf(e1), eb = __expf(blast);
                const float kv = valid ? (t ? bfhi(kc[e2]) : bflo(kc[e2])) : 0.f, qv = t ? bfhi(qc[e2]) : bflo(qc[e2]);
                qev[t] = qv * 0.125f * e1; kev[t] = kv * e2r;
                *(LAS unsigned short*)(kdt + kdl * 144 + lane * 2) = (unsigned short)f2bf(kev[t] * eb);
                if (lane == 0) DDp[item * 64 + kd] = eb; }
            qo[e2] = cvt_pk_bf16(qev[0], qev[1]); ko[e2] = cvt_pk_bf16(kev[0], kev[1]); }
        if (valid) { *(v4u*)(qdst + 8 * i) = (v4u){qo[0], qo[1], qo[2], qo[3]}; *(v4u*)(kdst + 8 * i) = (v4u){ko[0], ko[1], ko[2], ko[3]}; }
    }
    const int n = lane & 15, quad = lane >> 4;
#pragma unroll 1
    for (int vhf = 0; vhf < 2; ++vhf) {
        if (vhf == 1) {
#pragma unroll
            for (int i = 0; i < 8; ++i) { const int rr = (lane >> 3) + 8 * i, ch = lane & 7; v4u val = (v4u){0u, 0u, 0u, 0u};
                if (rr < ntok) val = *(const v4u*)(P + (size_t)(base + rr) * NIN + 1024 + h * 128 + 64 + ch * 8);
                *(LAS v4u*)(vs + rr * 144 + ch * 16) = val; } }
        bf16x8 bv[2][4];
#pragma unroll
        for (int p = 0; p < 2; ++p)
#pragma unroll
            for (int vt = 0; vt < 4; ++vt) {
#pragma unroll
                for (int e = 0; e < 8; ++e) bv[p][vt][e] = (short)*(const LAS unsigned short*)(vs + (p * 32 + quad * 8 + e) * 144 + (vt * 16 + n) * 2); }
#pragma unroll
        for (int kt = 0; kt < 2; ++kt) {
            const bf16x8 a0 = *(const LAS bf16x8*)(kdt + (kt * 16 + n) * 144 + (quad * 8) * 2), a1 = *(const LAS bf16x8*)(kdt + (kt * 16 + n) * 144 + (32 + quad * 8) * 2);
#pragma unroll
            for (int vt = 0; vt < 4; ++vt) { f32x4 acc = (f32x4){0.f, 0.f, 0.f, 0.f};
                acc = __builtin_amdgcn_mfma_f32_16x16x32_bf16(a0, bv[0][vt], acc, 0, 0, 0); acc = __builtin_amdgcn_mfma_f32_16x16x32_bf16(a1, bv[1][vt], acc, 0, 0, 0);
                const int v = vhf * 64 + vt * 16 + n;
                *(f32x4*)(UT + ((size_t)item * 128 + v) * 64 + 32 * kh + kt * 16 + quad * 4) = acc; }
        }
    }
    asm volatile("s_waitcnt lgkmcnt(0)" ::: "memory");
}

__device__ __forceinline__ void gla_sample_item(int it, LAS unsigned char* wl, int lane, const bf16* P, const float* ZR, const float* w_gk_up, const float* b_gk,
                                                const float* state_in, float* state_out, const float* g_gla_norm, bf16* OB) {
    const int sb = it >> 2, h = it & 3, base = R_SAMPLE + sb * 4;
    LAS float* qs = (LAS float*)wl; LAS float* ks = qs + 256; LAS float* ds = ks + 256;
    GateCol gc;
#pragma unroll
    for (int r = 0; r < 16; ++r) gc.w[r] = w_gk_up[r * 256 + h * 64 + lane];
    gc.bias = b_gk[h * 64 + lane];
    float bcum[4], qv[4], kv[4]; float bc = 0.f;
#pragma unroll
    for (int j = 0; j < 4; ++j) { bc += gate_logdecay(gc, ZR, base + j); bcum[j] = bc;
        qv[j] = bf2f(P[(size_t)(base + j) * NIN + 512 + h * 64 + lane]); kv[j] = bf2f(P[(size_t)(base + j) * NIN + 768 + h * 64 + lane]); }
    float qe[4], ke[4];
#pragma unroll
    for (int j = 0; j < 4; ++j) { qe[j] = qv[j] * 0.125f * __expf(bcum[j]); ke[j] = kv[j] * __expf(-bcum[j]);
        qs[j * 64 + lane] = qe[j]; ks[j * 64 + lane] = kv[j] * __expf(bcum[3] - bcum[j]); }
    ds[lane] = __expf(bcum[3]);
    float att[4][4];
#pragma unroll
    for (int i = 0; i < 4; ++i)
#pragma unroll
        for (int j = 0; j < 4; ++j) att[i][j] = (j <= i) ? wave_sum(qe[i] * ke[j]) : 0.f;
    asm volatile("s_waitcnt lgkmcnt(0)" ::: "memory");
    float vv[4][2];
#pragma unroll
    for (int j = 0; j < 4; ++j) { vv[j][0] = bf2f(P[(size_t)(base + j) * NIN + 1024 + h * 128 + lane]); vv[j][1] = bf2f(P[(size_t)(base + j) * NIN + 1024 + h * 128 + 64 + lane]); }
    float o[4][2];
#pragma unroll
    for (int i = 0; i < 4; ++i) { o[i][0] = 0.f; o[i][1] = 0.f; }
    const float* sin_ = state_in + (size_t)it * 8192; float* sout = state_out + (size_t)it * 8192;
#pragma unroll 16
    for (int kd = 0; kd < 64; ++kd) {
        const float s0 = sin_[kd * 128 + lane], s1 = sin_[kd * 128 + 64 + lane];
        const float dk = ds[kd];
        float n0 = dk * s0, n1 = dk * s1;
#pragma unroll
        for (int i = 0; i < 4; ++i) { const float q = qs[i * 64 + kd], k = ks[i * 64 + kd]; o[i][0] += q * s0; o[i][1] += q * s1; n0 += k * vv[i][0]; n1 += k * vv[i][1]; }
        sout[kd * 128 + lane] = n0; sout[kd * 128 + 64 + lane] = n1;
    }
    const float gn0 = g_gla_norm[lane], gn1 = g_gla_norm[64 + lane];
#pragma unroll
    for (int i = 0; i < 4; ++i) {
#pragma unroll
        for (int j = 0; j < 4; ++j) if (j <= i) { o[i][0] += att[i][j] * vv[j][0]; o[i][1] += att[i][j] * vv[j][1]; }
        const float ss = wave_sum(o[i][0] * o[i][0] + o[i][1] * o[i][1]); const float rstd = rsqrtf(ss * (1.f / 128.f) + RMS_EPS);
        const float g0 = bf2f(P[(size_t)(base + i) * NIN + 1536 + h * 128 + lane]), g1 = bf2f(P[(size_t)(base + i) * NIN + 1536 + h * 128 + 64 + lane]);
        OB[(size_t)(base + i) * 512 + h * 128 + lane] = (bf16)f2bf(o[i][0] * rstd * gn0 * g0 * sigm(g0));
        OB[(size_t)(base + i) * 512 + h * 128 + 64 + lane] = (bf16)f2bf(o[i][1] * rstd * gn1 * g1 * sigm(g1));
    }
    asm volatile("s_waitcnt lgkmcnt(0)" ::: "memory");
}

__device__ __forceinline__ void ld8(const bf16* p, float (&v)[8]) { const v4u w = *(const v4u*)p; v[0] = bflo(w.x); v[1] = bfhi(w.x); v[2] = bflo(w.y); v[3] = bfhi(w.y); v[4] = bflo(w.z); v[5] = bfhi(w.z); v[6] = bflo(w.w); v[7] = bfhi(w.w); }
__device__ __forceinline__ void ld8f(const float* p, float (&v)[8]) { const f32x4 a = *(const f32x4*)p, b = *(const f32x4*)(p + 4); v[0] = a[0]; v[1] = a[1]; v[2] = a[2]; v[3] = a[3]; v[4] = b[0]; v[5] = b[1]; v[6] = b[2]; v[7] = b[3]; }
__device__ __forceinline__ void st8f(float* p, const float (&v)[8]) { *(f32x4*)p = (f32x4){v[0], v[1], v[2], v[3]}; *(f32x4*)(p + 4) = (f32x4){v[4], v[5], v[6], v[7]}; }
__device__ __forceinline__ void pool_item(int r, int lane, const bf16* P, const float* state_pool, bf16* POOLED, bf16* OB, float* out) {
    const int c0 = lane * 8, w = 2 << (lane >> 4);
    if (r >= R_END) { *(v4u*)(POOLED + (size_t)r * 512 + c0) = (v4u){0u, 0u, 0u, 0u}; *(v4u*)(OB + (size_t)r * 512 + c0) = (v4u){0u, 0u, 0u, 0u}; return; }
    float u[8], s[8]; ld8(P + (size_t)r * NIN + c0, u);
#pragma unroll
    for (int e = 0; e < 8; ++e) s[e] = u[e];
    float cnt = (float)w;
    if (r < R_SAMPLE) { const int b = r >> 11, t = r & 2047;
#pragma unroll
        for (int d = 1; d < 16; ++d) { const int tp = t - d; const int row = tp >= 0 ? r - d : R_META + b * 16 + 16 + tp; float x[8];
            ld8(P + (size_t)row * NIN + c0, x); const float mk = d < w ? 1.f : 0.f;
#pragma unroll
            for (int e = 0; e < 8; ++e) s[e] += mk * x[e]; }
        if (t >= 2033) st8f(out + O_PBP + ((size_t)(b * 15 + (t - 2033))) * 512 + c0, u);
    } else if (r < R_META) { const int sb = (r - R_SAMPLE) >> 2, st = (r - R_SAMPLE) & 3;
#pragma unroll
        for (int d = 1; d < 16; ++d) { const int tp = st - d; float x[8];
            if (tp >= 0) ld8(P + (size_t)(r - d) * NIN + c0, x); else ld8f(state_pool + ((size_t)sb * 15 + 15 + tp) * 512 + c0, x);
            const float mk = d < w ? 1.f : 0.f;
#pragma unroll
            for (int e = 0; e < 8; ++e) s[e] += mk * x[e]; }
        st8f(out + O_PBS + ((size_t)sb * 15 + 11 + st) * 512 + c0, u);
        if (st == 0) for (int k = 0; k < 11; ++k) { float x[8]; ld8f(state_pool + ((size_t)sb * 15 + 4 + k) * 512 + c0, x); st8f(out + O_PBS + ((size_t)sb * 15 + k) * 512 + c0, x); }
    } else { const int i = (r - R_META) & 15;
#pragma unroll
        for (int d = 1; d < 16; ++d) { float x[8];
            if (i - d >= 0) { ld8(P + (size_t)(r - d) * NIN + c0, x); const float mk = d < w ? 1.f : 0.f;
#pragma unroll
                for (int e = 0; e < 8; ++e) s[e] += mk * x[e]; } }
        cnt = (float)(w < i + 1 ? w : i + 1);
    }
    const float inv = 1.f / cnt;
    v4u o; o.x = cvt_pk_bf16(s[0] * inv - u[0], s[1] * inv - u[1]); o.y = cvt_pk_bf16(s[2] * inv - u[2], s[3] * inv - u[3]);
    o.z = cvt_pk_bf16(s[4] * inv - u[4], s[5] * inv - u[5]); o.w = cvt_pk_bf16(s[6] * inv - u[6], s[7] * inv - u[7]);
    *(v4u*)(POOLED + (size_t)r * 512 + c0) = o;
}

template <int IH>
__device__ __forceinline__ void gla_c_item(int item, LAS unsigned char* wl, int lane, const bf16* P, const bf16* QE, const bf16* KE, const bf16* SINT, const float* g_gla_norm, bf16* OB) {
    const int c = item % NCH, bh = item / NCH, b = bh >> 2, h = bh & 3;
    const int base = c == 0 ? R_META + b * 16 : b * 2048 + (c - 1) * 64, ntok = c == 0 ? 16 : 64;
    const int n = lane & 15, quad = lane >> 4;
#pragma unroll
    for (int i = 0; i < 16; ++i) { const int row = (lane >> 4) + 4 * i, ch = lane & 15; v4u val = (v4u){0u, 0u, 0u, 0u};
        if (row < ntok) val = *(const v4u*)(P + (size_t)(base + row) * NIN + 1024 + h * 128 + ch * 8);
        *(LAS v4u*)(wl + row * 272 + ch * 16) = val; }
    bf16x8 qf[2][2];
#pragma unroll
    for (int li = 0; li < 2; ++li)
#pragma unroll
        for (int p = 0; p < 2; ++p) qf[li][p] = *(const bf16x8*)(QE + (size_t)(base + (2 * IH + li) * 16 + n) * 256 + h * 64 + p * 32 + quad * 8);
    constexpr int NJT = 2 * IH + 2;
    bf16x8 kf[NJT][2];
#pragma unroll
    for (int jt = 0; jt < NJT; ++jt)
#pragma unroll
        for (int p = 0; p < 2; ++p) kf[jt][p] = *(const bf16x8*)(KE + (size_t)(base + jt * 16 + n) * 256 + h * 64 + p * 32 + quad * 8);
    v4u af[2][IH + 1];
#pragma unroll
    for (int li = 0; li < 2; ++li) { const int itile = 2 * IH + li;
        f32x4 t[2 * IH + 2];
#pragma unroll
        for (int jt = 0; jt < 2 * IH + 2; ++jt) { f32x4 s = (f32x4){0.f, 0.f, 0.f, 0.f};
            if (jt <= itile) { s = __builtin_amdgcn_mfma_f32_16x16x32_bf16(kf[jt][0], qf[li][0], s, 0, 0, 0); s = __builtin_amdgcn_mfma_f32_16x16x32_bf16(kf[jt][1], qf[li][1], s, 0, 0, 0);
                if (jt == itile) {
#pragma unroll
                    for (int jj = 0; jj < 4; ++jj) if (quad * 4 + jj > n) s[jj] = 0.f; } }
            t[jt] = s; }
#pragma unroll
        for (int p = 0; p <= IH; ++p) { v4u a; a.x = cvt_pk_bf16(t[2 * p][0], t[2 * p][1]); a.y = cvt_pk_bf16(t[2 * p][2], t[2 * p][3]); a.z = cvt_pk_bf16(t[2 * p + 1][0], t[2 * p + 1][1]); a.w = cvt_pk_bf16(t[2 * p + 1][2], t[2 * p + 1][3]); af[li][p] = a; }
    }
    f32x4 acc[2][8];
#pragma unroll
    for (int li = 0; li < 2; ++li)
#pragma unroll
        for (int vt = 0; vt < 8; ++vt) acc[li][vt] = (f32x4){0.f, 0.f, 0.f, 0.f};
#pragma unroll
    for (int p = 0; p <= IH; ++p)
#pragma unroll
        for (int vt = 0; vt < 8; ++vt) { bf16x8 bvf;
#pragma unroll
            for (int e = 0; e < 8; ++e) { const int j = 32 * p + (e >> 2) * 16 + quad * 4 + (e & 3); bvf[e] = (short)*(const LAS unsigned short*)(wl + j * 272 + (vt * 16 + n) * 2); }
#pragma unroll
            for (int li = 0; li < 2; ++li) acc[li][vt] = __builtin_amdgcn_mfma_f32_16x16x32_bf16(__builtin_bit_cast(bf16x8, af[li][p]), bvf, acc[li][vt], 0, 0, 0); }
#pragma unroll
    for (int p = 0; p < 2; ++p)
#pragma unroll
        for (int vt = 0; vt < 8; ++vt) { const bf16x8 sf = *(const bf16x8*)(SINT + ((size_t)item * 128 + vt * 16 + n) * 64 + p * 32 + quad * 8);
#pragma unroll
            for (int li = 0; li < 2; ++li) acc[li][vt] = __builtin_amdgcn_mfma_f32_16x16x32_bf16(qf[li][p], sf, acc[li][vt], 0, 0, 0); }
#pragma unroll
    for (int li = 0; li < 2; ++li) { float ss[4] = {0.f, 0.f, 0.f, 0.f};
#pragma unroll
        for (int vt = 0; vt < 8; ++vt)
#pragma unroll
            for (int jj = 0; jj < 4; ++jj) ss[jj] += acc[li][vt][jj] * acc[li][vt][jj];
#pragma unroll
        for (int jj = 0; jj < 4; ++jj) { float s = ss[jj]; s += __shfl_xor(s, 1); s += __shfl_xor(s, 2); s += __shfl_xor(s, 4); s += __shfl_xor(s, 8);
            const float rstd = rsqrtf(s * (1.f / 128.f) + RMS_EPS); const int il = (2 * IH + li) * 16 + quad * 4 + jj;
            if (il < ntok) { const size_t row = (size_t)(base + il);
#pragma unroll
                for (int vt = 0; vt < 8; ++vt) { const int v = vt * 16 + n; const float og = bf2f(P[row * NIN + 1536 + h * 128 + v]);
                    OB[row * 512 + h * 128 + v] = (bf16)f2bf(acc[li][vt][jj] * rstd * g_gla_norm[v] * og * sigm(og)); } } }
    }
    asm volatile("s_waitcnt lgkmcnt(0)" ::: "memory");
}

__global__ void __launch_bounds__(NTHREADS, 2) mega_fwd(Args args) {
    extern __shared__ __attribute__((aligned(16))) unsigned char lds_raw[];
    LAS unsigned char* lds = (LAS unsigned char*)lds_raw;
    const int tid = threadIdx.x, lane = tid & 63, wave = __builtin_amdgcn_readfirstlane(tid >> 6);
    const int G = gridDim.x, gw = blockIdx.x * NWAVES + wave, NGW = G * NWAVES;
    LAS unsigned char* wl = lds + wave * WAVE_LDS;
    unsigned char* ws = args.ws; float* out = args.out;
    const float *x_prompt = args.in[0], *x_sample = args.in[1], *state_pool = args.in[2], *state_gla = args.in[3], *meta_tokens = args.in[4], *g_mix = args.in[5], *w_in = args.in[6], *w_gk_up = args.in[7], *b_gk = args.in[8],
                *w_pool_group = args.in[9], *pool_scale = args.in[10], *w_pool_proj = args.in[11], *g_gla_norm = args.in[12], *w_gla_proj = args.in[13], *w_out = args.in[14], *g_ffn = args.in[15], *w_ffn_in = args.in[16],
                *w_ffn_out = args.in[17], *g_final = args.in[18];
    bf16 *WinT = (bf16*)(ws + WS_WIN), *WcombT = (bf16*)(ws + WS_WCOMB), *WgpT = (bf16*)(ws + WS_WGP), *WoutT = (bf16*)(ws + WS_WOUT), *WfiT = (bf16*)(ws + WS_WFI), *WfoT = (bf16*)(ws + WS_WFO);
    float* ZR = (float*)(ws + WS_ZR); bf16* XN = (bf16*)(ws + WS_XN); bf16* MG = XN; bf16* P = (bf16*)(ws + WS_P); bf16* ACT = P; bf16* X1B = (bf16*)(ws + WS_X1B);
    bf16 *QE = (bf16*)(ws + WS_QE), *KE = (bf16*)(ws + WS_KE), *POOLED = (bf16*)(ws + WS_POOLED), *OB = (bf16*)(ws + WS_OB);
    float *XS = (float*)(ws + WS_XS), *SSP1 = (float*)(ws + WS_SSP1); float* PART = (float*)(ws + WS_XN);
    float* UT = out + OS_UT; bf16* SINT = (bf16*)(out + OS_SINT); float* DDp = out + OS_DD;
    const pg8::RowMap RM{x_prompt, x_sample, meta_tokens, out, XS};
    if (tid < 64) *(volatile LAS unsigned*)(lds + MISC_OFF + tid * 4) = 0u;
    __syncthreads();
    const XcdBarrier bar = xcd_barrier_post((unsigned*)(ws + WS_CTL), (volatile LAS unsigned*)(lds + MISC_OFF));
#define GRID_SYNC() xcd_barrier(bar)
#ifndef PROBE_MASK
#define PROBE_MASK 0
#endif
#define NREP(k) (((PROBE_MASK >> (k)) & 1) ? 2 : 1)

    for (int rep = 0; rep < NREP(0); ++rep) {
        LAS float* scr = (LAS float*)wl;
        constexpr int I_IN = 16 * 129, I_GP = 8 * 32, I_OUT = 16 * 32, I_FI = 16 * 176, I_FO = 44 * 32, I_ALL = I_IN + I_GP + I_OUT + I_FI + I_FO;
        for (int it = gw; it < I_ALL; it += NGW) {
            int r = it;
            if (r < I_IN) { const int kb = r / 129, n0 = (r % 129) * 32; tr_item(w_in, INDIM, WinT, 1024, kb * 64, n0 < 2048 ? n0 : (n0 < 4096 ? n0 + 16 : 2048), n0, nullptr, scr, lane); continue; } r -= I_IN;
            if (r < I_GP) { const int kb = r / 32, n0 = (r % 32) * 32; tr_item(w_gla_proj, 1024, WgpT, 512, kb * 64, n0, n0, nullptr, scr, lane); continue; } r -= I_GP;
            if (r < I_OUT) { const int kb = r / 32, n0 = (r % 32) * 32; tr_item(w_out, 1024, WoutT, 1024, kb * 64, n0, n0, nullptr, scr, lane); continue; } r -= I_OUT;
            if (r < I_FI) { const int kb = r / 176, n0 = (r % 176) * 32; const int pn = n0 >> 8, wi = n0 & 255; const int src = wi < 128 ? 128 * pn + wi : FF + 128 * pn + (wi - 128);
                tr_item(w_ffn_in, 2 * FF, WfiT, 1024, kb * 64, src, n0, g_ffn, scr, lane); continue; } r -= I_FI;
            { const int kb = r / 32, n0 = (r % 32) * 32; tr_item(w_ffn_out, 1024, WfoT, FF, kb * 64, n0, n0, nullptr, scr, lane); }
        }
        for (int idx = blockIdx.x * NTHREADS + tid; idx < 128 * 1024; idx += G * NTHREADS) {
            const int gq = __builtin_amdgcn_readfirstlane(idx >> 10), n = idx & 1023, g = gq >> 5;
            const float* wg = w_pool_group + (size_t)gq * 4 * 128; const float* sc = pool_scale + g * 128; const float* wp = w_pool_proj + (size_t)(g * 128) * 1024 + n;
            float a0 = 0.f, a1 = 0.f, a2 = 0.f, a3 = 0.f;
#pragma unroll 16
            for (int d = 0; d < 128; ++d) { const float t = sc[d] * wp[(size_t)d * 1024]; a0 += wg[d] * t; a1 += wg[128 + d] * t; a2 += wg[256 + d] * t; a3 += wg[384 + d] * t; }
            *(v2u*)(WcombT + (size_t)n * 512 + gq * 4) = (v2u){cvt_pk_bf16(a0, a1), cvt_pk_bf16(a2, a3)};
        }
        for (int idx = blockIdx.x * NTHREADS + tid; idx < (NINP - 4128) * 128; idx += G * NTHREADS) ((v4u*)(WinT + (size_t)4128 * 1024))[idx] = (v4u){0u, 0u, 0u, 0u};
        float gm[16];
#pragma unroll
        for (int i = 0; i < 16; ++i) gm[i] = g_mix[lane + 64 * i];
        float xn[16];
        { const float* xr0 = pg8::xrow_ptr(RM, gw);
#pragma unroll
          for (int i = 0; i < 16; ++i) xn[i] = xr0 ? xr0[lane + 64 * i] : 0.f; }
        for (int r = gw; r < MP; r += NGW) {
            float x[16]; float ss = 0.f;
#pragma unroll
            for (int i = 0; i < 16; ++i) { x[i] = xn[i]; ss += x[i] * x[i]; }
            { const int rn = r + NGW; const float* xr1 = rn < MP ? pg8::xrow_ptr(RM, rn) : nullptr;
#pragma unroll
              for (int i = 0; i < 16; ++i) xn[i] = xr1 ? xr1[lane + 64 * i] : 0.f; }
            const float rstd = rsqrtf(wave_sum(ss) * (1.f / DM) + RMS_EPS);
#pragma unroll
            for (int i = 0; i < 16; ++i) XN[(size_t)r * DM + lane + 64 * i] = (bf16)f2bf(x[i] * rstd * gm[i]);
        }
    }
    GRID_SYNC();
    for (int rep = 0; rep < NREP(1); ++rep) {
        pg8::Gemm g{XN, WinT, 1024, 1024}; pg8::StaticOrder S; S.init(MP, NINP, G, (int)blockIdx.x);
        pg8::EpiIn E{P, ZR};
        pg8::gemm_phase<pg8::EpiIn, pg8::StaticOrder, true, true>(lds, g, S, E);
    }
    GRID_SYNC();
    for (int rep = 0; rep < NREP(2); ++rep) {
        constexpr int N_A = 2 * NITEM, N_S = 512, N_ALL = N_A + N_S + MP;
        (void)N_ALL; const int skip = NGW >= 1024 ? N_A - NGW : 0;
        for (int it = gw; it < N_A; it += NGW) gla_a_item(it, wl, lane, P, ZR, w_gk_up, b_gk, QE, KE, UT, DDp);
        if (gw >= skip) { for (int it = gw - skip; it < N_S; it += NGW - skip) gla_sample_item(it, wl, lane, P, ZR, w_gk_up, b_gk, state_gla, out + O_GSS, g_gla_norm, OB);
            for (int r = gw - skip; r < MP; r += NGW - skip) pool_item(r, lane, P, state_pool, POOLED, OB, out); }
    }
    GRID_SYNC();
    for (int rep = 0; rep < NREP(3); ++rep)
    for (int e = blockIdx.x * NTHREADS + tid; e < NBH * 8192; e += G * NTHREADS) {
        const int bh = e >> 13, rem = e & 8191, v = rem >> 6, kd = rem & 63;
        float S = 0.f;
#pragma unroll 11
        for (int c = 0; c < NCH; ++c) { const size_t item = (size_t)bh * NCH + c;
            SINT[(item * 128 + v) * 64 + kd] = (bf16)f2bf(S);
            S = DDp[item * 64 + kd] * S + UT[(item * 128 + v) * 64 + kd]; }
        out[O_GSP + ((size_t)bh * 64 + kd) * 128 + v] = S;
    }
    GRID_SYNC();
    for (int rep = 0; rep < NREP(4); ++rep) {
        constexpr int N_C = 2 * NITEM;
        for (int it = gw; it < N_C; it += NGW) { const int item = it >> 1;
            if ((it & 1) == 0) gla_c_item<0>(item, wl, lane, P, QE, KE, SINT, g_gla_norm, OB);
            else if (item % NCH != 0) gla_c_item<1>(item, wl, lane, P, QE, KE, SINT, g_gla_norm, OB); }
    }
    GRID_SYNC();
    for (int rep = 0; rep < NREP(5); ++rep) {
        pg8::Gemm g{POOLED, WcombT, 512, 512}; pg8::PairOrder S; S.init(G, (int)blockIdx.x);
        pg8::EpiMerge E{P, MG};
        pg8::gemm_phase<pg8::EpiMerge, pg8::PairOrder, true, true>(lds, g, S, E);
    }
    GRID_SYNC();
    for (int rep = 0; rep < NREP(6); ++rep) {
        pg8::Gemm g{MG, WoutT, 1024, 1024}; pg8::StaticOrder S; S.init(M2, DM, G, (int)blockIdx.x);
        pg8::EpiRes1 E{RM, X1B, SSP1};
        pg8::gemm_phase<pg8::EpiRes1, pg8::StaticOrder, true, true>(lds, g, S, E);
    }
    GRID_SYNC();
    for (int rep = 0; rep < NREP(7); ++rep) {
        pg8::Gemm g{X1B, WfiT, 1024, 1024}; pg8::StaticOrder S; S.init(M2, 2 * FF, G, (int)blockIdx.x);
        pg8::EpiSwiglu E{SSP1, ACT, FF};
        pg8::gemm_phase<pg8::EpiSwiglu, pg8::StaticOrder, true, true>(lds, g, S, E);
    }
    GRID_SYNC();
    {
        pg8::Gemm g{ACT, WfoT, FF, FF}; pg8::StaticOrder S; S.init(R_SAMPLE, DM, G, (int)blockIdx.x);
        pg8::EpiRes2 E{RM};
        pg8::gemm_phase<pg8::EpiRes2, pg8::StaticOrder, true, true>(lds, g, S, E);
        pg8::Gemm g2{ACT, WfoT, FF, pg8::KSPLIT}; pg8::MiniOrder S2{G, (int)blockIdx.x};
        pg8::EpiPart E2{PART};
        pg8::gemm_phase<pg8::EpiPart, pg8::MiniOrder, true, true>(lds, g2, S2, E2);
    }
    GRID_SYNC();
    {
        f32x4 gf[4];
#pragma unroll
        for (int j = 0; j < 4; ++j) gf[j] = *(const f32x4*)(g_final + 4 * lane + 256 * j);
        for (int r0 = gw; r0 < M2; r0 += 2 * NGW) {
            f32x4 v[2][4];
#pragma unroll
            for (int q = 0; q < 2; ++q) { const int r = r0 + q * NGW;
                if (r < M2) {
#pragma unroll
                    for (int j = 0; j < 4; ++j) { v[q][j] = *(const f32x4*)(out + (size_t)r * DM + 4 * lane + 256 * j);
                        if (r >= R_SAMPLE) for (int sp = 0; sp < pg8::NSPLIT; ++sp) v[q][j] += *(const f32x4*)(PART + ((size_t)sp * 512 + (r - R_SAMPLE)) * DM + 4 * lane + 256 * j); } } }
#pragma unroll
            for (int q = 0; q < 2; ++q) { const int r = r0 + q * NGW;
                if (r < M2) { float ss = 0.f;
#pragma unroll
                    for (int j = 0; j < 4; ++j) ss += (v[q][j][0] * v[q][j][0] + v[q][j][1] * v[q][j][1]) + (v[q][j][2] * v[q][j][2] + v[q][j][3] * v[q][j][3]);
                    const float rstd = rsqrtf(wave_sum(ss) * (1.f / DM) + RMS_EPS);
#pragma unroll
                    for (int j = 0; j < 4; ++j) *(f32x4*)(out + (size_t)r * DM + 4 * lane + 256 * j) = v[q][j] * rstd * gf[j]; } }
        }
    }
}

extern "C" void kernel_launch(void* const* d_in, const int* in_sizes, int n_in, void* d_out, int out_size, void* d_ws, size_t ws_size, hipStream_t stream) {
    static int grid = 0;
    if (grid == 0) {
        if (n_in != 19 || (size_t)out_size != O_TOTAL || ws_size < WS_END) { fprintf(stderr, "kernel_launch: unexpected shapes (n_in %d out %d ws %zu)\n", n_in, out_size, ws_size); grid = -1; return; }
        int dev = 0, cus = 0, per_cu = 0;
        if (hipGetDevice(&dev) != hipSuccess || hipDeviceGetAttribute(&cus, hipDeviceAttributeMultiprocessorCount, dev) != hipSuccess) { grid = -1; return; }
        if (hipFuncSetAttribute((const void*)mega_fwd, hipFuncAttributeMaxDynamicSharedMemorySize, LDS_BYTES) != hipSuccess) { fprintf(stderr, "kernel_launch: hipFuncSetAttribute failed\n"); grid = -1; return; }
        if (hipOccupancyMaxActiveBlocksPerMultiprocessor(&per_cu, (const void*)mega_fwd, NTHREADS, LDS_BYTES) != hipSuccess || per_cu < 1) { fprintf(stderr, "kernel_launch: occupancy query says %d\n", per_cu); grid = -1; return; }
        grid = cus;
    }
    if (grid < 0) return;
    if (hipMemsetAsync((char*)d_ws + WS_CTL, 0, CTL_ZERO_BYTES, stream) != hipSuccess) { fprintf(stderr, "kernel_launch: memset failed\n"); return; }
    Args a{};
    for (int i = 0; i < 19; ++i) a.in[i] = (const float*)d_in[i];
    a.out = (float*)d_out; a.ws = (unsigned char*)d_ws;
    hipLaunchKernelGGL(mega_fwd, dim3(grid), dim3(NTHREADS), LDS_BYTES, stream, a);
    const hipError_t e = hipPeekAtLastError();
    if (e != hipSuccess) fprintf(stderr, "kernel_launch: launch failed: %s (grid %d)\n", hipGetErrorString(e), grid);
}
```
